# Optimizing an MI355X kernel written in HIP

```python
import math
import jax, jax.numpy as jnp
from jax import lax
import numpy as np

D_MODEL = 2048
BATCH = 1
SEQ = 8192
DEPTH = 2
DEC_BATCH = 8
DEC_SEQ = 16
PAST_LEN = 4096

CHUNK = 64
QBLOCK = 128
HEAD_DIM = 128
EPS = 1e-6
POOL_WIDTH = D_MODEL // 2
POOL_WINDOWS = (2, 4, 8, 16)
N_POOL_GROUPS = len(POOL_WINDOWS)
POOL_GROUP = POOL_WIDTH // N_POOL_GROUPS
POOL_STATE = max(POOL_WINDOWS) - 1
FOX_WIDTH = D_MODEL - POOL_WIDTH
FOX_HEADS = FOX_WIDTH // HEAD_DIM
SB_HEADS = D_MODEL // HEAD_DIM
IN_AB = POOL_WIDTH + 3 * FOX_WIDTH + FOX_HEADS
D_FF = -(-8 * D_MODEL // (3 * 256)) * 256
N_EVEN = (DEPTH + 1) // 2
N_ODD = DEPTH // 2

kernel_name = 'pool_fox_stickbreak_streaming_encoder_step'


def rmsnorm(x, g):
    xf = x.astype(jnp.float32)
    y = xf * lax.rsqrt(jnp.mean(xf * xf, axis=-1, keepdims=True) + EPS)
    return (y * g.astype(jnp.float32)).astype(x.dtype)


def swiglu(h, w_gate, w_up, w_down):
    return (jax.nn.silu(h @ w_gate) * (h @ w_up)) @ w_down


def pool_mixer(u, prefix, pos, w_pool, pool_scale):
    b, t, _ = u.shape
    up = jnp.concatenate([prefix.astype(u.dtype), u], axis=1)
    cs = jnp.pad(jnp.cumsum(up.astype(jnp.float32), axis=1), ((0, 0), (1, 0), (0, 0)))
    end = cs[:, POOL_STATE + 1:]
    means = []
    for g, w in enumerate(POOL_WINDOWS):
        ch = slice(g * POOL_GROUP, (g + 1) * POOL_GROUP)
        start = cs[:, POOL_STATE + 1 - w:POOL_STATE + 1 - w + t, ch]
        count = jnp.minimum(pos + 1, w).astype(jnp.float32)[None, :, None]
        means.append((end[:, :, ch] - start) / count)
    d = jnp.concatenate(means, axis=-1) - u.astype(jnp.float32)
    d = d.astype(u.dtype).reshape(b, t, N_POOL_GROUPS, POOL_GROUP)
    y = jnp.einsum('btgc,gce->btge', d, w_pool).reshape(b, t, POOL_WIDTH)
    return y * pool_scale, up[:, -POOL_STATE:]


def fox_block(q, cum_q, q_pos, k, v, cum_k, k_pos):
    s = jnp.einsum('bqhd,bkhd->bhqk', q, k, preferred_element_type=jnp.float32) * (HEAD_DIM ** -0.5)
    s = s + jnp.transpose(cum_q, (0, 2, 1))[..., None] - jnp.transpose(cum_k, (0, 2, 1))[:, :, None, :]
    mask = k_pos[None, :] <= q_pos[:, None]
    p = jax.nn.softmax(jnp.where(mask, s, -jnp.inf), axis=-1)
    return jnp.einsum('bhqk,bkhd->bqhd', p.astype(v.dtype), v)


def sb_block(q, q_pos, k, v, k_pos):
    z = jnp.einsum('bqhd,bkhd->bhqk', q, k, preferred_element_type=jnp.float32) * (HEAD_DIM ** -0.5)
    mask = k_pos[None, :] < q_pos[:, None]
    log_beta = jax.nn.log_sigmoid(z)
    log_rest = jnp.where(mask, jax.nn.log_sigmoid(-z), 0.0)
    later = lax.cumsum(log_rest, axis=3, reverse=True) - log_rest
    a = jnp.where(mask, jnp.exp(log_beta + later), 0.0)
    return jnp.einsum('bhqk,bkhd->bqhd', a.astype(v.dtype), v)


def sweep_queries(fn, q_args, q_pos, kv_args):
    t = q_pos.shape[0]
    if t <= QBLOCK:
        return fn(*q_args, q_pos, *kv_args)
    nb = t // QBLOCK

    def split(a):
        return jnp.moveaxis(a.reshape(a.shape[0], nb, QBLOCK, *a.shape[2:]), 1, 0)

    blocks = tuple(split(a) for a in q_args) + (q_pos.reshape(nb, QBLOCK),)
    out = lax.map(lambda blk: fn(*blk[:-1], blk[-1], *kv_args), blocks)
    return jnp.moveaxis(out, 0, 1).reshape(out.shape[1], t, *out.shape[3:])


def pool_fox_mixer(h, pos, pool_prev, k_prev, v_prev, lf_prev, w_in, b_f, w_pool, pool_scale, w_out):
    b, t, _ = h.shape
    z = h @ w_in
    cuts = [POOL_WIDTH, POOL_WIDTH + FOX_WIDTH, POOL_WIDTH + 2 * FOX_WIDTH, POOL_WIDTH + 3 * FOX_WIDTH]
    u, q, k, v, f_logit = jnp.split(z, cuts, axis=-1)
    y_pool, pool_state = pool_mixer(u, pool_prev, pos, w_pool, pool_scale)
    q = q.reshape(b, t, FOX_HEADS, HEAD_DIM)
    k = k.reshape(b, t, FOX_HEADS, HEAD_DIM)
    v = v.reshape(b, t, FOX_HEADS, HEAD_DIM)
    log_f = jax.nn.log_sigmoid((f_logit + b_f).astype(jnp.float32))
    k_all = jnp.concatenate([k_prev.astype(k.dtype), k], axis=1)
    v_all = jnp.concatenate([v_prev.astype(v.dtype), v], axis=1)
    cum_f = jnp.cumsum(jnp.concatenate([lf_prev.astype(jnp.float32), log_f], axis=1), axis=1)
    n_past = k_prev.shape[1]
    k_pos = jnp.arange(n_past + t)
    o = sweep_queries(fox_block, (q, cum_f[:, n_past:]), pos, (k_all, v_all, cum_f, k_pos))
    y = jnp.concatenate([y_pool, o.reshape(b, t, FOX_WIDTH).astype(y_pool.dtype)], axis=-1) @ w_out
    return y, pool_state, k, v, log_f


def sb_mixer(h, pos, k_prev, v_prev, w_qkv, w_out):
    b, t, _ = h.shape
    q, k, v = jnp.split(h @ w_qkv, 3, axis=-1)
    q = q.reshape(b, t, SB_HEADS, HEAD_DIM)
    k = k.reshape(b, t, SB_HEADS, HEAD_DIM)
    v = v.reshape(b, t, SB_HEADS, HEAD_DIM)
    k_all = jnp.concatenate([k_prev.astype(k.dtype), k], axis=1)
    v_all = jnp.concatenate([v_prev.astype(v.dtype), v], axis=1)
    k_pos = jnp.arange(k_prev.shape[1] + t)
    o = sweep_queries(sb_block, (q,), pos, (k_all, v_all, k_pos))
    return o.reshape(b, t, D_MODEL) @ w_out, k, v


def run_trunk(x, pos, pool_c, fk_c, fv_c, flf_c, sk_c, sv_c, ln_mix, w_in_ab, b_forget, w_pool,
              pool_scale, w_out_ab, w_qkv_sb, w_out_sb, ln_ffn, w_gate, w_up, w_down, ln_final):
    h = x
    pool_s, fk_s, fv_s, flf_s, sk_s, sv_s = [], [], [], [], [], []
    for layer in range(DEPTH):
        hn = rmsnorm(h, ln_mix[layer])
        i = layer // 2
        if layer % 2 == 0:
            y, ps, k, v, lf = pool_fox_mixer(hn, pos, pool_c[i], fk_c[i], fv_c[i], flf_c[i], w_in_ab[i],
                                             b_forget[i], w_pool[i], pool_scale[i], w_out_ab[i])
            pool_s.append(ps)
            fk_s.append(k)
            fv_s.append(v)
            flf_s.append(lf)
        else:
            y, k, v = sb_mixer(hn, pos, sk_c[i], sv_c[i], w_qkv_sb[i], w_out_sb[i])
            sk_s.append(k)
            sv_s.append(v)
        h = h + y
        h = h + swiglu(rmsnorm(h, ln_ffn[layer]), w_gate[layer], w_up[layer], w_down[layer])
    return (rmsnorm(h, ln_final), jnp.stack(pool_s), jnp.stack(fk_s), jnp.stack(fv_s),
            jnp.stack(flf_s), jnp.stack(sk_s), jnp.stack(sv_s))


def setup_inputs(seed: int = 0) -> dict:
    key = jax.random.key(seed)
    keys = iter(jax.random.split(key, 32))

    def nrm(shape, scale=1.0):
        return scale * jax.random.normal(next(keys), shape, jnp.float32)

    return {
        'x_prompt': nrm((BATCH, SEQ, D_MODEL)),
        'x_sample': nrm((DEC_BATCH, DEC_SEQ, D_MODEL)),
        'cache_pool': nrm((N_EVEN, DEC_BATCH, POOL_STATE, POOL_WIDTH)),
        'cache_fox_k': nrm((N_EVEN, DEC_BATCH, PAST_LEN, FOX_HEADS, HEAD_DIM)),
        'cache_fox_v': nrm((N_EVEN, DEC_BATCH, PAST_LEN, FOX_HEADS, HEAD_DIM)),
        'cache_fox_logf': jax.nn.log_sigmoid(2.0 + nrm((N_EVEN, DEC_BATCH, PAST_LEN, FOX_HEADS), 0.5)),
        'cache_sb_k': nrm((N_ODD, DEC_BATCH, PAST_LEN, SB_HEADS, HEAD_DIM)),
        'cache_sb_v': nrm((N_ODD, DEC_BATCH, PAST_LEN, SB_HEADS, HEAD_DIM)),
        'ln_mix': 1.0 + nrm((DEPTH, D_MODEL), 0.05),
        'w_in_ab': nrm((N_EVEN, D_MODEL, IN_AB), D_MODEL ** -0.5),
        'b_forget': 2.0 + nrm((N_EVEN, FOX_HEADS), 0.5),
        'w_pool': nrm((N_EVEN, N_POOL_GROUPS, POOL_GROUP, POOL_GROUP), POOL_GROUP ** -0.5),
        'pool_scale': 1.0 + nrm((N_EVEN, POOL_WIDTH), 0.05),
        'w_out_ab': nrm((N_EVEN, D_MODEL, D_MODEL), D_MODEL ** -0.5),
        'w_qkv_sb': nrm((N_ODD, D_MODEL, 3 * D_MODEL), D_MODEL ** -0.5),
        'w_out_sb': nrm((N_ODD, D_MODEL, D_MODEL), D_MODEL ** -0.5),
        'ln_ffn': 1.0 + nrm((DEPTH, D_MODEL), 0.05),
        'w_gate': nrm((DEPTH, D_MODEL, D_FF), D_MODEL ** -0.5),
        'w_up': nrm((DEPTH, D_MODEL, D_FF), D_MODEL ** -0.5),
        'w_down': nrm((DEPTH, D_FF, D_MODEL), D_FF ** -0.5),
        'ln_final': 1.0 + nrm((D_MODEL,), 0.05),
    }


def reference(x_prompt, x_sample, cache_pool, cache_fox_k, cache_fox_v, cache_fox_logf, cache_sb_k,
              cache_sb_v, ln_mix, w_in_ab, b_forget, w_pool, pool_scale, w_out_ab, w_qkv_sb, w_out_sb,
              ln_ffn, w_gate, w_up, w_down, ln_final):
    if x_sample.shape[1] > CHUNK:
        raise ValueError('a later request holds at most one chunk of frames')
    b, s, _ = x_prompt.shape
    dt = x_prompt.dtype
    weights = (ln_mix, w_in_ab, b_forget, w_pool, pool_scale, w_out_ab, w_qkv_sb, w_out_sb,
               ln_ffn, w_gate, w_up, w_down, ln_final)
    y_p, pool_p, fk_p, fv_p, flf_p, sk_p, sv_p = run_trunk(
        x_prompt, jnp.arange(s),
        jnp.zeros((N_EVEN, b, POOL_STATE, POOL_WIDTH), dt),
        jnp.zeros((N_EVEN, b, 0, FOX_HEADS, HEAD_DIM), dt),
        jnp.zeros((N_EVEN, b, 0, FOX_HEADS, HEAD_DIM), dt),
        jnp.zeros((N_EVEN, b, 0, FOX_HEADS), jnp.float32),
        jnp.zeros((N_ODD, b, 0, SB_HEADS, HEAD_DIM), dt),
        jnp.zeros((N_ODD, b, 0, SB_HEADS, HEAD_DIM), dt),
        *weights)
    n_past = cache_fox_k.shape[2]
    y_s, pool_s, fk_s, fv_s, flf_s, sk_s, sv_s = run_trunk(
        x_sample, n_past + jnp.arange(x_sample.shape[1]),
        cache_pool, cache_fox_k, cache_fox_v, cache_fox_logf, cache_sb_k, cache_sb_v,
        *weights)
    return (y_p, y_s, pool_p, fk_p, fv_p, flf_p, sk_p, sv_p, pool_s, fk_s, fv_s, flf_s, sk_s, sv_s)
```

```cpp
#include <hip/hip_runtime.h>
#include <cstdio>
#include <cstdint>

#define LAS __attribute__((address_space(3)))
#define GAS __attribute__((address_space(1)))
typedef unsigned short bf16;
typedef short bf16x8 __attribute__((ext_vector_type(8)));
typedef short s16x4 __attribute__((ext_vector_type(4)));
typedef float f32x4 __attribute__((ext_vector_type(4)));
typedef float f32x2 __attribute__((ext_vector_type(2)));
typedef float f32x16 __attribute__((ext_vector_type(16)));
typedef unsigned u32x4 __attribute__((ext_vector_type(4)));
typedef unsigned u32x2 __attribute__((ext_vector_type(2)));
typedef GAS unsigned gu32;

constexpr int DM = 2048, SEQ = 8192, DECB = 8, DECS = 16, PAST = 4096, NS = DECB * DECS, MP = SEQ + NS, MPAD = 8448;
constexpr int PW = 1024, FW = 1024, FH = 8, SH = 16, HD = 128, INAB = 4104, DFF = 5632, NKS = PAST + DECS;
constexpr float EPS = 1e-6f;
constexpr float SCALE = 0.08838834764831845f, RSCALE = 11.313708498984761f, LOG2E = 1.4426950408889634f;
constexpr int NWAVES = 8, NT = 512;
#ifndef PHMASK
#define PHMASK 0xffffffffu
#endif
#define PH(k) ((PHMASK >> (k)) & 1u)
#ifndef DUP
#define DUP -1
#endif
#define REP(k) for (int rep_ = 0; rep_ < ((DUP) == (k) ? 2 : 1); ++rep_)

constexpr size_t O_YP = 0, O_YS = O_YP + (size_t)SEQ * DM, O_POOLP = O_YS + (size_t)NS * DM, O_FKP = O_POOLP + 15 * PW, O_FVP = O_FKP + (size_t)SEQ * FW,
                 O_FLFP = O_FVP + (size_t)SEQ * FW, O_SKP = O_FLFP + (size_t)SEQ * FH, O_SVP = O_SKP + (size_t)SEQ * DM, O_POOLS = O_SVP + (size_t)SEQ * DM,
                 O_FKS = O_POOLS + (size_t)DECB * 15 * PW, O_FVS = O_FKS + (size_t)NS * FW, O_FLFS = O_FVS + (size_t)NS * FW, O_SKS = O_FLFS + (size_t)NS * FH,
                 O_SVS = O_SKS + (size_t)NS * DM, O_END = O_SVS + (size_t)NS * DM;
static_assert(O_END == 68362240, "output size");

constexpr size_t MiB = 1u << 20;
constexpr size_t al1(size_t x) { return (x + MiB - 1) / MiB * MiB; }
constexpr size_t WS_CTL = 0, CTL_ZERO_BYTES = 1 * MiB;
constexpr size_t WS_WIN = 1 * MiB;
constexpr size_t WS_WF = WS_WIN + al1((size_t)4096 * DM * 2);
constexpr size_t WS_WPOOL = WS_WF + al1((size_t)16 * DM * 2);
constexpr size_t WS_WOUT0 = WS_WPOOL + al1((size_t)1024 * 256 * 2);
constexpr size_t WS_WGU0 = WS_WOUT0 + al1((size_t)DM * DM * 2);
constexpr size_t WS_WDN0 = WS_WGU0 + al1((size_t)2 * DFF * DM * 2);
constexpr size_t WS_WQKV = WS_WDN0 + al1((size_t)DM * DFF * 2);
constexpr size_t WS_WOUT1 = WS_WQKV + al1((size_t)3 * DM * DM * 2);
constexpr size_t WS_WGU1 = WS_WOUT1 + al1((size_t)DM * DM * 2);
constexpr size_t WS_WDN1 = WS_WGU1 + al1((size_t)2 * DFF * DM * 2);
constexpr size_t WS_XB = WS_WDN1 + al1((size_t)DM * DFF * 2);
constexpr size_t WS_U = WS_XB + al1((size_t)MPAD * DM * 2);
constexpr size_t WS_QB = WS_U + al1((size_t)MPAD * PW * 4);
constexpr size_t WS_KB = WS_QB + al1((size_t)MPAD * DM * 2);
constexpr size_t WS_VB = WS_KB + al1((size_t)MPAD * DM * 2);
constexpr size_t WS_DB = WS_VB + al1((size_t)MPAD * DM * 2);
constexpr size_t WS_CAT = WS_DB + al1((size_t)MPAD * PW * 2);
constexpr size_t WS_H = WS_CAT + al1((size_t)MPAD * DM * 2);
constexpr size_t WS_HB = WS_H + al1((size_t)MPAD * DM * 4);
constexpr size_t WS_ACT = WS_HB + al1((size_t)MPAD * DM * 2);
constexpr size_t WS_LF = WS_ACT + al1((size_t)MPAD * DFF * 2);
constexpr size_t WS_CUMP = WS_LF + al1((size_t)MPAD * 8 * 4);
constexpr size_t WS_CUMS = WS_CUMP + al1((size_t)SEQ * 8 * 4);
constexpr size_t WS_SCRH = WS_CUMS + al1((size_t)DECB * NKS * 8 * 4);
constexpr size_t WS_SCRHB = WS_SCRH + al1((size_t)MPAD * DM * 4);
constexpr size_t WS_END = WS_SCRHB + al1((size_t)MPAD * DM * 2);

constexpr int CW_TMO = 0, CW_BAR = 4096, CW_KMAX = 8192  , CW_FCNT = 12288  , CW_QHEAD = 14464  , CW_SHEAD = 15360  , CW_SSQ = 16384;
static_assert((CW_SSQ + 6 * MPAD) * 4 <= (int)CTL_ZERO_BYTES, "ctl");

constexpr int RING_BYTES = 131072, LDSCTL_OFF = RING_BYTES, MISC_OFF = LDSCTL_OFF + 320, LDS_BYTES = 147456;

__device__ __forceinline__ unsigned cvt_pk_bf16(float lo, float hi) { unsigned r; asm volatile("v_cvt_pk_bf16_f32 %0, %1, %2" : "=v"(r) : "v"(lo), "v"(hi)); return r; }
__device__ __forceinline__ bf16x8 pack8(f32x4 a, f32x4 b) { u32x4 w = {cvt_pk_bf16(a[0], a[1]), cvt_pk_bf16(a[2], a[3]), cvt_pk_bf16(b[0], b[1]), cvt_pk_bf16(b[2], b[3])}; return __builtin_bit_cast(bf16x8, w); }
__device__ __forceinline__ float wave_sum(float v) {
#pragma unroll
    for (int o = 1; o < 64; o <<= 1) v += __shfl_xor(v, o);
    return v;
}
__device__ __forceinline__ int otid() { int t = threadIdx.x; asm volatile("" : "+v"(t)); return t; }
__device__ __forceinline__ float fexp2(float x) { return __builtin_amdgcn_exp2f(x); }
__device__ __forceinline__ float flog2(float x) { return __builtin_amdgcn_logf(x); }

#define XB_TMO      128
#define XB_XCNT(j)  (256  + 64 * (j))
#define XB_XSUB(j)  (1280 + 64 * (j))
#define XB_XGEN(j)  (2304 + 64 * (j))
#define XB_TOP      3328
#define XB_TOPGEN   3392
#define XCD_BAR_WORDS 3456
#define XB_SPIN_CAP (1u << 22)
__device__ __forceinline__ unsigned xb_ld(unsigned* p)              { return __hip_atomic_load(p, __ATOMIC_RELAXED, __HIP_MEMORY_SCOPE_AGENT); }
__device__ __forceinline__ unsigned xb_add(unsigned* p, unsigned v) { return __hip_atomic_fetch_add(p, v, __ATOMIC_RELAXED, __HIP_MEMORY_SCOPE_AGENT); }
__device__ __forceinline__ unsigned xb_xcc_id() { return (unsigned)__builtin_amdgcn_s_getreg((3 << 11) | 20) & 0xFu; }
#define XB_SPIN(cond, bar) do { unsigned _sp = 0; while (cond) { __builtin_amdgcn_s_sleep(1); \
    if ((++_sp & 255u) == 0u) { if (xb_ld(&(bar)[XB_TMO])) break; if (_sp > XB_SPIN_CAP) { atomicAdd(&(bar)[XB_TMO], 1u); break; } } } } while (0)
struct XcdBarrier { unsigned* bar; unsigned x; volatile LAS unsigned* st; };
__device__ __forceinline__ XcdBarrier xcd_barrier_post(unsigned* bar, volatile LAS unsigned* st) {
    XcdBarrier b; b.bar = bar; b.x = xb_xcc_id(); b.st = st;
    if (threadIdx.x == 0) (void)xb_add(&bar[XB_XCNT(b.x)], 1u);
    return b;
}
__device__ __forceinline__ void xcd_barrier_complete(unsigned* bar, unsigned x, unsigned& nloc, unsigned& nx) {
    const unsigned G = gridDim.x * gridDim.y * gridDim.z;
    unsigned sum, cnt, mine, sp = 0u;
    for (;;) {
        sum = 0u; cnt = 0u; mine = 0u;
#pragma unroll
        for (unsigned j = 0; j < 16; ++j) { const unsigned c = xb_ld(&bar[XB_XCNT(j)]); sum += c; cnt += (c > 0u) ? 1u : 0u; mine = (j == x) ? c : mine; }
        if (sum == G) break;
        __builtin_amdgcn_s_sleep(1);
        if ((++sp & 255u) == 0u) { if (xb_ld(&bar[XB_TMO])) break; if (sp > XB_SPIN_CAP) { atomicAdd(&bar[XB_TMO], 1u); break; } }
    }
    nloc = mine > 0u ? mine : 1u; nx = cnt > 0u ? cnt : 1u;
}
__device__ __forceinline__ void xcd_barrier(const XcdBarrier& b) {
    asm volatile("s_waitcnt vmcnt(0)" ::: "memory");
    __syncthreads();
    if (threadIdx.x == 0) {
        unsigned* bar = b.bar;
        __builtin_amdgcn_s_waitcnt(0);
        unsigned nloc = b.st[0], nx = b.st[1];
        if (nloc == 0u) { xcd_barrier_complete(bar, b.x, nloc, nx); b.st[0] = nloc; b.st[1] = nx; }
        const unsigned old = xb_add(&bar[XB_XSUB(b.x)], 1u);
        const unsigned gen = old / nloc;
        if (old + 1u == (gen + 1u) * nloc) {
            __builtin_amdgcn_fence(__ATOMIC_RELEASE, "agent");
            asm volatile("s_waitcnt vmcnt(0)" ::: "memory");
            const unsigned og = xb_add(&bar[XB_TOP], 1u);
            const unsigned tg = og / nx;
            if (og + 1u == (tg + 1u) * nx) xb_add(&bar[XB_TOPGEN], 1u);
            else XB_SPIN(xb_ld(&bar[XB_TOPGEN]) == tg, bar);
            __builtin_amdgcn_fence(__ATOMIC_ACQUIRE, "agent");
            xb_add(&bar[XB_XGEN(b.x)], 1u);
            asm volatile("s_waitcnt vmcnt(0)" ::: "memory");
        } else {
            XB_SPIN(xb_ld(&bar[XB_XGEN(b.x)]) == gen, bar);
            __builtin_amdgcn_fence(__ATOMIC_ACQUIRE, "agent");
            asm volatile("s_waitcnt vmcnt(0)" ::: "memory");
        }
    }
    __syncthreads();
}

namespace pg8 {
constexpr int BM = 256, BK = 64, HALF = 128, HTB = HALF * BK * 2, NXCD = 8, WGM = 8;
__host__ __device__ __forceinline__ int lds_byte(int r, int c) { const int st = (r >> 4) * 2 + (c >> 5), rr = r & 15, cc = c & 31, ob = rr * 64 + cc * 2; return st * 1024 + (ob ^ (((ob >> 9) & 1) << 5)); }
__host__ __device__ __forceinline__ void stage_rc(int b, int& R, int& C) { const int st = b / 1024, sb = b % 1024, swz = sb ^ (((sb >> 9) & 1) << 5); R = (st >> 1) * 16 + swz / 64; C = (st & 1) * 32 + (swz % 64) / 2; }
__host__ __device__ __forceinline__ int perm32(int rho) { const int n = rho >> 4, i = rho & 15; return 8 * (i >> 2) + 4 * n + (i & 3); }
struct Unit { int pm, pn; };
struct Gemm { const bf16* A; const bf16* Bt; int lda, ldb, K, a_koff; };
struct StaticOrder {
    int nM, nN, nwg, G, c;
    __device__ void init(int nM_, int nN_, int G_, int c_) { nM = nM_; nN = nN_; nwg = nM * nN; G = G_; c = c_; }
    __device__ bool next(int i, Unit& u) const {
        const long L = (long)i * G + c; if (L >= nwg) return false;
        int wgid = (int)L; { const int q = nwg / NXCD, r = nwg % NXCD, xcd = wgid % NXCD, off = wgid / NXCD; wgid = (xcd < r ? xcd * (q + 1) : r * (q + 1) + (xcd - r) * q) + off; }
        const int nig = WGM * nN, gid = wgid / nig, fm = gid * WGM, gsz = (nM - fm) < WGM ? (nM - fm) : WGM;
        u.pm = fm + ((wgid % nig) % gsz); u.pn = (wgid % nig) / gsz; return true;
    }
};
struct BalancedOrder {
    int R, c, G;
    __device__ bool next(int i, Unit& u) const {
        if (G == 256) { if (i >= R) return false; const int xcd = c & 7, r = c >> 3; u.pm = (xcd >> 1) * 8 + (r & 7); u.pn = (2 * i + (xcd & 1)) * 4 + (r >> 3); return true; }
        const int L = i * G + c; if (L >= 32 * 8 * R) return false; u.pm = L & 31; u.pn = L >> 5; return true;
    }
};
template <class Epi, class Sched, bool ALIGN_EPI>
__device__ __forceinline__ void gemm_phase(LAS unsigned char* lds, const Gemm g, const Sched& S, const Epi& E) {
    const int tid = otid(), wid = __builtin_amdgcn_readfirstlane(tid >> 6), lane = tid & 63, wr = wid >> 2, wc = wid & 3, fr = lane & 15, fq = lane >> 4;
    const int K = g.K, nt = K / BK;
    unsigned voffA[2], voffB[2];
#pragma unroll
    for (int i = 0; i < 2; ++i) { int R, C; stage_rc(tid * 16 + i * 8192, R, C); const int Rb = (R & ~31) + perm32(R & 31);
        voffA[i] = (unsigned)(R * g.lda + C) * 2u; voffB[i] = (unsigned)(Rb * g.ldb + C) * 2u; }
    const size_t kstep = (size_t)(BK * 2);
    const size_t hstepA = (size_t)HALF * g.lda * 2, hstepB = (size_t)HALF * g.ldb * 2;
    const size_t tstepA = 2 * hstepA, tstepB = 2 * hstepB;
    const unsigned ldsw = (unsigned)wid * 1024u;
    const int aoff = lds_byte(wr * 64 + fr, fq * 8), boff = lds_byte(wc * 32 + fr, fq * 8);
#define PG8_SA(b, h) (((b) * 2 + (h)) * HTB)
#define PG8_SB(b, h) ((4 + (b) * 2 + (h)) * HTB)
    const unsigned ldsb0 = (unsigned)(uintptr_t)lds + ldsw;
#define PG8_STAGE(bufoff, gbase, voff) do { _Pragma("unroll") for (int _i = 0; _i < 2; ++_i) { unsigned keep_; \
        asm volatile("s_mov_b32 %0, m0\n\ts_mov_b32 m0, %3\n\ts_nop 0\n\tglobal_load_lds_dwordx4 %1, %2\n\ts_mov_b32 m0, %0" \
            : "=&s"(keep_) : "v"((voff)[_i]), "s"((const void*)(gbase)), "s"(ldsb0 + (unsigned)(bufoff) + (unsigned)(_i * 8192)) : "memory"); } } while (0)
#define PG8_LDA(dst, b, h) do { _Pragma("unroll") for (int m = 0; m < 4; ++m) _Pragma("unroll") for (int k = 0; k < 2; ++k) dst[m][k] = *(const LAS bf16x8*)(lds + PG8_SA(b, h) + aoff + m * 2048 + k * 1024); } while (0)
#define PG8_LDB(dst, b, h) do { _Pragma("unroll") for (int n = 0; n < 2; ++n) _Pragma("unroll") for (int k = 0; k < 2; ++k) dst[n][k] = *(const LAS bf16x8*)(lds + PG8_SB(b, h) + boff + n * 2048 + k * 1024); } while (0)
#define PG8_MMA(ai, bj, At, Bt) do { __builtin_amdgcn_s_setprio(1); _Pragma("unroll") for (int m = 0; m < 4; ++m) _Pragma("unroll") for (int n = 0; n < 2; ++n) _Pragma("unroll") for (int k = 0; k < 2; ++k) \
        acc[ai][bj][m][n] = __builtin_amdgcn_mfma_f32_16x16x32_bf16(Bt[n][k], At[m][k], acc[ai][bj][m][n], 0, 0, 0); __builtin_amdgcn_s_setprio(0); } while (0)
#define PG8_WAIT_V(n) asm volatile("s_waitcnt vmcnt(" #n ")" ::: "memory")
#define PG8_WAIT_L(n) asm volatile("s_waitcnt lgkmcnt(" #n ")" ::: "memory")
#define PG8_BAR __builtin_amdgcn_s_barrier()
#define PG8_SCHED __builtin_amdgcn_sched_barrier(0)
    Unit cur, nxt; int ui = 0;
    if (!S.next(0, cur)) return;
    f32x4 acc[2][2][4][2];
#pragma unroll
    for (int a = 0; a < 2; ++a)
#pragma unroll
        for (int b = 0; b < 2; ++b)
#pragma unroll
            for (int m = 0; m < 4; ++m)
#pragma unroll
                for (int n = 0; n < 2; ++n) acc[a][b][m][n] = (f32x4){0.f, 0.f, 0.f, 0.f};
    bf16x8 At[4][2], B0[2][2], B1[2][2];
    float pre[Epi::NPRE > 0 ? Epi::NPRE : 1];
    if constexpr (Epi::NPRE > 0) E.preload(cur, wr, fr, pre);
    const char* cA = (const char*)g.A + (size_t)cur.pm * tstepA + (size_t)cur.pn * g.a_koff * 2; const char* cB = (const char*)g.Bt + (size_t)cur.pn * tstepB;
    PG8_STAGE(PG8_SB(0, 0), cB, voffB); PG8_STAGE(PG8_SB(0, 1), cB + hstepB, voffB); PG8_STAGE(PG8_SA(0, 0), cA, voffA); PG8_STAGE(PG8_SA(0, 1), cA + hstepA, voffA);
    if (wr == 1) PG8_BAR;
    PG8_WAIT_V(2); PG8_BAR;
    PG8_STAGE(PG8_SB(1, 0), cB + kstep, voffB); PG8_STAGE(PG8_SA(1, 0), cA + kstep, voffA); PG8_STAGE(PG8_SB(1, 1), cB + hstepB + kstep, voffB);
    PG8_WAIT_V(6); PG8_BAR;
    for (;;) {
        const bool has_next = S.next(ui + 1, nxt);
        const char* nA = has_next ? (const char*)g.A + (size_t)nxt.pm * tstepA + (size_t)nxt.pn * g.a_koff * 2 : cA; const char* nB = has_next ? (const char*)g.Bt + (size_t)nxt.pn * tstepB : cB;
#pragma unroll 1
        for (int t = 0; t < nt; t += 2) {
            const bool last = (t == nt - 2);
            const char* a1 = cA + (size_t)(t + 1) * kstep;
            const char* a2 = last ? nA : cA + (size_t)(t + 2) * kstep; const char* b2 = last ? nB : cB + (size_t)(t + 2) * kstep;
            const char* a3 = a2 + kstep; const char* b3 = b2 + kstep;
            PG8_LDB(B0, 0, 0); PG8_LDB(B1, 0, 1); PG8_SCHED; PG8_LDA(At, 0, 0); PG8_STAGE(PG8_SA(1, 1), a1 + hstepA, voffA);
            PG8_WAIT_V(8); PG8_WAIT_L(0); PG8_BAR; PG8_MMA(0, 0, At, B0); PG8_MMA(0, 1, At, B1); PG8_BAR; PG8_SCHED;
            PG8_LDA(At, 0, 1); PG8_STAGE(PG8_SB(0, 0), b2, voffB); PG8_STAGE(PG8_SB(0, 1), b2 + hstepB, voffB); PG8_STAGE(PG8_SA(0, 0), a2, voffA);
            PG8_WAIT_V(8); PG8_WAIT_L(0); PG8_BAR; PG8_MMA(1, 0, At, B0); PG8_MMA(1, 1, At, B1); PG8_BAR; PG8_SCHED;
            PG8_LDB(B0, 1, 0); PG8_LDB(B1, 1, 1); PG8_SCHED; PG8_LDA(At, 1, 0); PG8_STAGE(PG8_SA(0, 1), a2 + hstepA, voffA);
            PG8_WAIT_V(8); PG8_WAIT_L(0); PG8_BAR; PG8_MMA(0, 0, At, B0); PG8_MMA(0, 1, At, B1); PG8_BAR; PG8_SCHED;
            PG8_LDA(At, 1, 1); PG8_STAGE(PG8_SB(1, 0), b3, voffB); PG8_STAGE(PG8_SB(1, 1), b3 + hstepB, voffB); PG8_STAGE(PG8_SA(1, 0), a3, voffA);
            PG8_WAIT_V(8); PG8_WAIT_L(0); PG8_BAR; PG8_MMA(1, 0, At, B0); PG8_MMA(1, 1, At, B1); PG8_BAR; PG8_SCHED;
        }
        if constexpr (ALIGN_EPI) { if (wr == 0) PG8_BAR; }
        if constexpr (Epi::NPRE > 0) E(acc, cur, wr, wc, fr, fq, pre); else
        if constexpr (!Epi::AFTER_DRAIN) E(acc, cur, wr, wc, fr, fq);
        if (!has_next) break;
#pragma unroll
        for (int a = 0; a < 2; ++a)
#pragma unroll
            for (int b = 0; b < 2; ++b)
#pragma unroll
                for (int m = 0; m < 4; ++m)
#pragma unroll
                    for (int n = 0; n < 2; ++n) acc[a][b][m][n] = (f32x4){0.f, 0.f, 0.f, 0.f};
        cur = nxt; cA = nA; cB = nB; ++ui;
        if constexpr (Epi::NPRE > 0) E.preload(cur, wr, fr, pre);
        if constexpr (ALIGN_EPI) { if (wr == 1) PG8_BAR; }
    }
    PG8_WAIT_V(0);
    if constexpr (!ALIGN_EPI) { if (wr == 0) PG8_BAR; }
    PG8_BAR;
    if constexpr (Epi::AFTER_DRAIN) E.after(acc, cur, wr, wc, fr, fq);
#undef PG8_SA
#undef PG8_SB
#undef PG8_STAGE
#undef PG8_LDA
#undef PG8_LDB
#undef PG8_MMA
#undef PG8_WAIT_V
#undef PG8_WAIT_L
#undef PG8_BAR
#undef PG8_SCHED
}
}

typedef f32x4 Acc[2][2][4][2];
__device__ __forceinline__ float rs_of(const float* ssq, int row) { return __builtin_amdgcn_rsqf(ssq[row] * (1.f / DM) + EPS); }
__device__ __forceinline__ float rs_val(float ssqv) { return __builtin_amdgcn_rsqf(ssqv * (1.f / DM) + EPS); }
__device__ __forceinline__ void st_bf16x8(bf16* p, f32x4 a, f32x4 b) { *(bf16x8*)p = pack8(a, b); }

struct EpiIn {
    static constexpr int NPRE = 8;
    static constexpr bool AFTER_DRAIN = false;
    const float* ssq; bf16* UB; float* poolp; bf16* QB; bf16* KB; bf16* VB; float* fk; float* fv;
    __device__ __forceinline__ void preload(const pg8::Unit& u, int wr, int fr, float* rsv) const {
#pragma unroll
        for (int k = 0; k < 8; ++k) rsv[k] = ssq[u.pm * 256 + (k >> 2) * 128 + wr * 64 + (k & 3) * 16 + fr]; }
    __device__ __forceinline__ void operator()(const Acc& acc, const pg8::Unit& u, int wr, int wc, int fr, int fq, const float* rsv) const {
        const int sec = u.pn >> 2, cin = (u.pn & 3) * 256 + wc * 32 + fq * 8;
#pragma unroll
        for (int ai = 0; ai < 2; ++ai)
#pragma unroll
            for (int m = 0; m < 4; ++m) { const int row = u.pm * 256 + ai * 128 + wr * 64 + m * 16 + fr; const float rs = rs_val(rsv[ai * 4 + m]);
#pragma unroll
                for (int bj = 0; bj < 2; ++bj) { const f32x4 v0 = acc[ai][bj][m][0] * rs, v1 = acc[ai][bj][m][1] * rs; const int c = cin + bj * 128;
                    if (sec == 0) { st_bf16x8(UB + (size_t)row * PW + c, v0, v1);
                        if (row >= SEQ - 15) { float* p = poolp + (size_t)(row - (SEQ - 15)) * PW + c; *(f32x4*)p = v0; *(f32x4*)(p + 4) = v1; } }
                    else if (sec == 1) st_bf16x8(QB + (size_t)row * DM + c, v0, v1);
                    else if (sec == 2) { float* p = fk + (size_t)row * FW + c; *(f32x4*)p = v0; *(f32x4*)(p + 4) = v1; st_bf16x8(KB + (size_t)row * DM + c, v0, v1); }
                    else { float* p = fv + (size_t)row * FW + c; *(f32x4*)p = v0; *(f32x4*)(p + 4) = v1; st_bf16x8(VB + (size_t)row * DM + c, v0, v1); } } }
    }
};
__device__ __forceinline__ void wg_max8(LAS float* km, float s, int lane, int wave, int tid, unsigned* dst) {
    __syncthreads();
    if ((lane & 0x31) == 0) km[wave * 8 + ((lane >> 1) & 7)] = s;
    __syncthreads();
    if (tid < 8) { float m = km[tid];
#pragma unroll
        for (int w2 = 1; w2 < 8; ++w2) m = fmaxf(m, km[w2 * 8 + tid]);
        atomicMax(dst + tid, __float_as_uint(m)); }
}
struct EpiQkv {
    static constexpr int NPRE = 8;
    static constexpr bool AFTER_DRAIN = false;
    const float* ssq; bf16* QB; bf16* KB; bf16* VB; float* sk; float* sv;
    __device__ __forceinline__ void preload(const pg8::Unit& u, int wr, int fr, float* rsv) const {
#pragma unroll
        for (int k = 0; k < 8; ++k) rsv[k] = ssq[u.pm * 256 + (k >> 2) * 128 + wr * 64 + (k & 3) * 16 + fr]; }
    __device__ __forceinline__ void operator()(const Acc& acc, const pg8::Unit& u, int wr, int wc, int fr, int fq, const float* rsv) const {
        const int sec = u.pn >> 3, cin = (u.pn & 7) * 256 + wc * 32 + fq * 8;
#pragma unroll
        for (int ai = 0; ai < 2; ++ai)
#pragma unroll
            for (int m = 0; m < 4; ++m) { const int row = u.pm * 256 + ai * 128 + wr * 64 + m * 16 + fr; const float rs = rs_val(rsv[ai * 4 + m]);
#pragma unroll
                for (int bj = 0; bj < 2; ++bj) { const f32x4 v0 = acc[ai][bj][m][0] * rs, v1 = acc[ai][bj][m][1] * rs; const int c = cin + bj * 128;
                    if (sec == 0) st_bf16x8(QB + (size_t)row * DM + c, v0, v1);
                    else if (sec == 1) { float* p = sk + (size_t)row * DM + c; *(f32x4*)p = v0; *(f32x4*)(p + 4) = v1; st_bf16x8(KB + (size_t)row * DM + c, v0, v1); }
                    else { float* p = sv + (size_t)row * DM + c; *(f32x4*)p = v0; *(f32x4*)(p + 4) = v1; st_bf16x8(VB + (size_t)row * DM + c, v0, v1); } } }
    }
};
struct EpiPool {
    static constexpr int NPRE = 0;
    static constexpr bool AFTER_DRAIN = false;
    const float* pscale; bf16* CAT;
    __device__ __forceinline__ void operator()(const Acc& acc, const pg8::Unit& u, int wr, int wc, int fr, int fq) const {
        f32x4 sc[2][2];
#pragma unroll
        for (int bj = 0; bj < 2; ++bj) { const int c = u.pn * 256 + bj * 128 + wc * 32 + fq * 8; sc[bj][0] = *(const f32x4*)(pscale + c); sc[bj][1] = *(const f32x4*)(pscale + c + 4); }
        __builtin_amdgcn_sched_barrier(0);
#pragma unroll
        for (int bj = 0; bj < 2; ++bj) { const int c = u.pn * 256 + bj * 128 + wc * 32 + fq * 8;
#pragma unroll
            for (int ai = 0; ai < 2; ++ai)
#pragma unroll
                for (int m = 0; m < 4; ++m) { const int row = u.pm * 256 + ai * 128 + wr * 64 + m * 16 + fr;
                    st_bf16x8(CAT + (size_t)row * DM + c, acc[ai][bj][m][0] * sc[bj][0], acc[ai][bj][m][1] * sc[bj][1]); } }
    }
};
__device__ __forceinline__ float bf2f(short b) { return __uint_as_float(((unsigned)(unsigned short)b) << 16); }
constexpr bool RES_LO = false;
__device__ __forceinline__ void ld_hilo(const bf16* hi, const bf16* lo, f32x4& a, f32x4& b) { const bf16x8 h = *(const bf16x8*)hi;
    if (RES_LO) { const bf16x8 l = *(const bf16x8*)lo;
#pragma unroll
        for (int e = 0; e < 4; ++e) { a[e] = bf2f(h[e]) + bf2f(l[e]); b[e] = bf2f(h[4 + e]) + bf2f(l[4 + e]); } }
    else {
#pragma unroll
        for (int e = 0; e < 4; ++e) { a[e] = bf2f(h[e]); b[e] = bf2f(h[4 + e]); } } }
__device__ __forceinline__ void st_hilo(bf16* hi, bf16* lo, f32x4 a, f32x4 b) { const bf16x8 h = pack8(a, b); *(bf16x8*)hi = h;
    if (RES_LO) { f32x4 ra, rb;
#pragma unroll
        for (int e = 0; e < 4; ++e) { ra[e] = a[e] - bf2f(h[e]); rb[e] = b[e] - bf2f(h[4 + e]); }
        *(bf16x8*)lo = pack8(ra, rb); } }
template <bool RESF32> struct EpiRes {
    static constexpr int NPRE = 0;
    static constexpr bool AFTER_DRAIN = false;
    const float* resf; bf16* HB; bf16* HL; float* ssq;
    __device__ __forceinline__ void operator()(const Acc& acc, const pg8::Unit& u, int wr, int wc, int fr, int fq) const {
        float sq[8];
#pragma unroll
        for (int ai = 0; ai < 2; ++ai) {
            f32x4 rf[RESF32 ? 4 : 1][2][2]; bf16x8 rb[RESF32 ? 1 : 4][2];
#pragma unroll
            for (int m = 0; m < 4; ++m)
#pragma unroll
                for (int bj = 0; bj < 2; ++bj) { const size_t o = (size_t)(u.pm * 256 + ai * 128 + wr * 64 + m * 16 + fr) * DM + u.pn * 256 + bj * 128 + wc * 32 + fq * 8;
                    if (RESF32) { rf[m][bj][0] = *(const f32x4*)(resf + o); rf[m][bj][1] = *(const f32x4*)(resf + o + 4); } else rb[m][bj] = *(const bf16x8*)(HB + o); }
            __builtin_amdgcn_sched_barrier(0);
#pragma unroll
            for (int m = 0; m < 4; ++m) { const int row = u.pm * 256 + ai * 128 + wr * 64 + m * 16 + fr; float s = 0.f;
#pragma unroll
                for (int bj = 0; bj < 2; ++bj) { const int c = u.pn * 256 + bj * 128 + wc * 32 + fq * 8; const size_t o = (size_t)row * DM + c;
                    f32x4 r0, r1;
                    if (RESF32) { r0 = rf[m][bj][0]; r1 = rf[m][bj][1]; }
                    else {
#pragma unroll
                        for (int e = 0; e < 4; ++e) { r0[e] = bf2f(rb[m][bj][e]); r1[e] = bf2f(rb[m][bj][4 + e]); } }
                    const f32x4 v0 = acc[ai][bj][m][0] + r0, v1 = acc[ai][bj][m][1] + r1;
                    st_hilo(HB + o, HL + o, v0, v1);
                    s += (v0[0] * v0[0] + v0[1] * v0[1]) + (v0[2] * v0[2] + v0[3] * v0[3]) + (v1[0] * v1[0] + v1[1] * v1[1]) + (v1[2] * v1[2] + v1[3] * v1[3]); }
                s += __shfl_xor(s, 16); s += __shfl_xor(s, 32); sq[ai * 4 + m] = s; }
        }
        if (fq == 0) {
#pragma unroll
            for (int k = 0; k < 8; ++k) atomicAdd(ssq + u.pm * 256 + (k >> 2) * 128 + wr * 64 + (k & 3) * 16 + fr, sq[k]); }
    }
};
__device__ __forceinline__ void wait_count(unsigned* cnt, unsigned need, unsigned* tmo) {
    __hip_atomic_fetch_add(cnt, 1u, __ATOMIC_RELAXED, __HIP_MEMORY_SCOPE_AGENT);
    unsigned sp = 0;
    while (__hip_atomic_load(cnt, __ATOMIC_RELAXED, __HIP_MEMORY_SCOPE_AGENT) < need) { __builtin_amdgcn_s_sleep(2);
        if ((++sp & 255u) == 0u) { if (__hip_atomic_load(tmo, __ATOMIC_RELAXED, __HIP_MEMORY_SCOPE_AGENT)) break; if (sp > (1u << 22)) { atomicAdd(tmo, 1u); break; } } }
}
struct EpiResFinal {
    static constexpr int NPRE = 0;
    static constexpr bool AFTER_DRAIN = true;
    const bf16* HB; const bf16* HL; float* Y; const float* lnf; float* ssq; unsigned* cnt; unsigned* tmo;
    __device__ __forceinline__ void operator()(const Acc&, const pg8::Unit&, int, int, int, int) const {}
    __device__ __forceinline__ void after(Acc& acc, const pg8::Unit& u, int wr, int wc, int fr, int fq) const {
        {
            bf16x8 rb[2][4][2];
#pragma unroll
            for (int ai = 0; ai < 2; ++ai)
#pragma unroll
                for (int m = 0; m < 4; ++m)
#pragma unroll
                    for (int bj = 0; bj < 2; ++bj) rb[ai][m][bj] = *(const bf16x8*)(HB + (size_t)(u.pm * 256 + ai * 128 + wr * 64 + m * 16 + fr) * DM + u.pn * 256 + bj * 128 + wc * 32 + fq * 8);
            __builtin_amdgcn_sched_barrier(0);
#pragma unroll
            for (int ai = 0; ai < 2; ++ai)
#pragma unroll
                for (int m = 0; m < 4; ++m) { const int row = u.pm * 256 + ai * 128 + wr * 64 + m * 16 + fr; float s = 0.f;
#pragma unroll
                    for (int bj = 0; bj < 2; ++bj) { f32x4 r0, r1;
#pragma unroll
                        for (int e = 0; e < 4; ++e) { r0[e] = bf2f(rb[ai][m][bj][e]); r1[e] = bf2f(rb[ai][m][bj][4 + e]); }
                        const f32x4 v0 = acc[ai][bj][m][0] + r0, v1 = acc[ai][bj][m][1] + r1;
                        acc[ai][bj][m][0] = v0; acc[ai][bj][m][1] = v1;
                        s += (v0[0] * v0[0] + v0[1] * v0[1]) + (v0[2] * v0[2] + v0[3] * v0[3]) + (v1[0] * v1[0] + v1[1] * v1[1]) + (v1[2] * v1[2] + v1[3] * v1[3]); }
                    s += __shfl_xor(s, 16); s += __shfl_xor(s, 32);
                    if (fq == 0) atomicAdd(ssq + row, s); }
        }
        asm volatile("s_waitcnt vmcnt(0)" ::: "memory");
        __syncthreads();
        if (threadIdx.x == 0) wait_count(cnt + 64 * u.pm, 8u, tmo);
        __syncthreads();
        float rsv[8]; f32x4 ln[2][2];
#pragma unroll
        for (int k = 0; k < 8; ++k) rsv[k] = __hip_atomic_load(ssq + u.pm * 256 + (k >> 2) * 128 + wr * 64 + (k & 3) * 16 + fr, __ATOMIC_RELAXED, __HIP_MEMORY_SCOPE_AGENT);
#pragma unroll
        for (int bj = 0; bj < 2; ++bj) { const int c = u.pn * 256 + bj * 128 + wc * 32 + fq * 8; ln[bj][0] = *(const f32x4*)(lnf + c); ln[bj][1] = *(const f32x4*)(lnf + c + 4); }
        __builtin_amdgcn_sched_barrier(0);
#pragma unroll
        for (int ai = 0; ai < 2; ++ai)
#pragma unroll
            for (int m = 0; m < 4; ++m) { const int row = u.pm * 256 + ai * 128 + wr * 64 + m * 16 + fr;
                const float rs = rs_val(rsv[ai * 4 + m]);
#pragma unroll
                for (int bj = 0; bj < 2; ++bj) { const int c = u.pn * 256 + bj * 128 + wc * 32 + fq * 8; float* yp = Y + (size_t)row * DM + c;
                    *(f32x4*)yp = acc[ai][bj][m][0] * rs * ln[bj][0]; *(f32x4*)(yp + 4) = acc[ai][bj][m][1] * rs * ln[bj][1]; } }
    }
};
__device__ __forceinline__ float swiglu1(float g, float u) { return g * u * __builtin_amdgcn_rcpf(1.f + fexp2(-g * LOG2E)); }
struct EpiGU {
    static constexpr int NPRE = 8;
    static constexpr bool AFTER_DRAIN = false;
    const float* ssq; bf16* ACT;
    __device__ __forceinline__ void preload(const pg8::Unit& u, int wr, int fr, float* rsv) const {
#pragma unroll
        for (int k = 0; k < 8; ++k) rsv[k] = ssq[u.pm * 256 + (k >> 2) * 128 + wr * 64 + (k & 3) * 16 + fr]; }
    __device__ __forceinline__ void operator()(const Acc& acc, const pg8::Unit& u, int wr, int wc, int fr, int fq, const float* rsv) const {
        const int c = u.pn * 128 + wc * 32 + fq * 8;
#pragma unroll
        for (int ai = 0; ai < 2; ++ai)
#pragma unroll
            for (int m = 0; m < 4; ++m) { const int row = u.pm * 256 + ai * 128 + wr * 64 + m * 16 + fr; const float rs = rs_val(rsv[ai * 4 + m]);
                f32x4 o0, o1;
#pragma unroll
                for (int e = 0; e < 4; ++e) { o0[e] = swiglu1(acc[ai][0][m][0][e] * rs, acc[ai][1][m][0][e] * rs); o1[e] = swiglu1(acc[ai][0][m][1][e] * rs, acc[ai][1][m][1][e] * rs); }
                st_bf16x8(ACT + (size_t)row * DFF + c, o0, o1); __builtin_amdgcn_sched_barrier(0); }
    }
};

template <int NB, int MT, class Map, class Epi>
__device__ __forceinline__ void small_gemm_t(LAS unsigned char* lds, int nunits, int lda, int ldb, int K, const Map& M_, const Epi& E, int G, int c) {
    static_assert(MT == 8 || (MT == 4 && NB == 1), "small_gemm geometry");
    const int tid = otid(), wid = __builtin_amdgcn_readfirstlane(tid >> 6), lane = tid & 63, fr = lane & 15, fq = lane >> 4;
    const int kw = K / 8, nks = kw / 32;
    LAS f32x4* red = (LAS f32x4*)lds;
    for (int t = c; t < nunits; t += G) {
        const int ct = MT == 8 ? t : (t >> 1), r0 = MT == 8 ? 0 : (t & 1) * 64;
        const bf16 *a, *b0, *b1; M_.get(ct, a, b0, b1); a += (size_t)r0 * lda;
        f32x4 acc[NB][MT];
#pragma unroll
        for (int j = 0; j < NB; ++j)
#pragma unroll
            for (int m = 0; m < MT; ++m) acc[j][m] = (f32x4){0.f, 0.f, 0.f, 0.f};
        const bf16* ap = a + (size_t)fr * lda + wid * kw + fq * 8;
        const bf16* bp0 = b0 + (size_t)fr * ldb + wid * kw + fq * 8;
        const bf16* bp1 = b1 + (size_t)fr * ldb + wid * kw + fq * 8;
        constexpr int UB = (NB == 1 ? 4 : 2) * (8 / MT);
#pragma unroll 1
        for (int ks = 0; ks < nks; ks += UB) {
            bf16x8 af[UB][MT], bf0[UB], bf1[UB];
#pragma unroll
            for (int u = 0; u < UB; ++u) if (ks + u < nks) {
#pragma unroll
                for (int m = 0; m < MT; ++m) af[u][m] = *(const bf16x8*)(ap + (size_t)m * 16 * lda + (ks + u) * 32);
                bf0[u] = *(const bf16x8*)(bp0 + (ks + u) * 32);
                if (NB == 2) bf1[u] = *(const bf16x8*)(bp1 + (ks + u) * 32); }
            __builtin_amdgcn_sched_barrier(0);
#pragma unroll
            for (int u = 0; u < UB; ++u) if (ks + u < nks) {
#pragma unroll
                for (int m = 0; m < MT; ++m) { acc[0][m] = __builtin_amdgcn_mfma_f32_16x16x32_bf16(bf0[u], af[u][m], acc[0][m], 0, 0, 0);
                    if (NB == 2) acc[NB - 1][m] = __builtin_amdgcn_mfma_f32_16x16x32_bf16(bf1[u], af[u][m], acc[NB - 1][m], 0, 0, 0); } }
            __builtin_amdgcn_sched_barrier(0);
        }
#pragma unroll
        for (int j = 0; j < NB; ++j)
#pragma unroll
            for (int m = 0; m < MT; ++m) red[(j * 64 + wid * 8 + m) * 64 + lane] = acc[j][m];
        __syncthreads();
        const bool act = MT == 8 || wid < MT;
        f32x4 v[NB];
        if (act) {
#pragma unroll
            for (int j = 0; j < NB; ++j) { v[j] = red[(j * 64 + wid) * 64 + lane];
#pragma unroll
                for (int s = 1; s < 8; ++s) v[j] += red[(j * 64 + s * 8 + wid) * 64 + lane]; }
        }
        if constexpr (Epi::TWO_STAGE) {
            f32x4 h = {0.f, 0.f, 0.f, 0.f};
            if (act) h = E.stage1(ct, r0 + wid * 16 + fr, fq * 4, v[0]);
            E.wait_all();
            if (act) E.stage2(ct, r0 + wid * 16 + fr, fq * 4, h);
        } else if (act) E(ct, r0 + wid * 16 + fr, fq * 4, v[0], v[NB - 1]);
        __syncthreads();
    }
}
template <int NB, class Map, class Epi>
__device__ __forceinline__ void small_gemm(LAS unsigned char* lds, int nunits, int lda, int ldb, int K, const Map& M_, const Epi& E, int G, int c) { small_gemm_t<NB, 8>(lds, nunits, lda, ldb, K, M_, E, G, c); }

namespace att {
constexpr int KVB = 64, SHM = KVB * HD * 2;
constexpr int L_V = 0, L_K = 4 * SHM, L_BIAS = LDSCTL_OFF + 1024, L_WS = L_BIAS + 4 * 256, L_FLAG = L_WS + NWAVES * 64 * 4, L_END = L_FLAG + 64;
static_assert(8 * SHM <= RING_BYTES && L_END <= LDS_BYTES, "attention LDS");
#define KSWZ(row, colB) ((row) * 256 + ((colB) ^ (((row) & 7) << 4)))
#define SBAR() __builtin_amdgcn_sched_barrier(0)
__device__ __forceinline__ int v_st(int k, int c) { const int kk = (k & ~0xC) | ((k & 4) << 1) | ((k & 8) >> 1); return ((kk >> 3) * 4 + (c >> 5)) * 512 + ((kk & 7) * 32 + (c & 31)) * 2; }
__device__ __forceinline__ int v_rd_base(int lane) { return ((lane & 3) << 3) | (((lane >> 2) & 3) << 6) | (((lane >> 4) & 1) << 5) | (((lane >> 5) & 1) << 8); }
constexpr int v_rd_off(int d0, int ks, int half) { return d0 * 512 + ks * 4096 + half * 2048; }
__device__ __forceinline__ int crow(int r, int hi) { return (r & 3) + 8 * (r >> 2) + 4 * hi; }

__device__ __forceinline__ void qkt(f32x16& p0, f32x16& p1, LAS const char* Kb, int r32, int hi, const bf16x8* qr) {
    LAS const char* kb[4];
#pragma unroll
    for (int dd = 0; dd < 4; ++dd) kb[dd] = Kb + KSWZ(r32, (dd * 16 + hi * 8) * 2);
#pragma unroll
    for (int d0 = 0; d0 < 8; ++d0) { LAS const char* a = kb[d0 & 3] + (d0 >> 2) * 128;
        const bf16x8 b0 = *(LAS const bf16x8*)a, b1 = *(LAS const bf16x8*)(a + 32 * 256);
        p0 = __builtin_amdgcn_mfma_f32_32x32x16_bf16(b0, qr[d0], p0, 0, 0, 0);
        p1 = __builtin_amdgcn_mfma_f32_32x32x16_bf16(b1, qr[d0], p1, 0, 0, 0); }
}
__device__ __forceinline__ void pv_tile(f32x16* o, unsigned vb0, bf16x8 pa0, bf16x8 pa1, bf16x8 pa2, bf16x8 pa3) {
#define TRRD(dst, off) asm volatile("ds_read_b64_tr_b16 %0, %1 offset:%2" : "=&v"(dst) : "v"(vb0), "i"(off) : "memory")
#define PV_D0(d0) do { s16x4 l0, l1, l2, l3, h0, h1, h2, h3; constexpr int b_ = v_rd_off(d0, 0, 0); \
        TRRD(l0, b_); TRRD(h0, b_ + 2048); TRRD(l1, b_ + 4096); TRRD(h1, b_ + 6144); TRRD(l2, b_ + 8192); TRRD(h2, b_ + 10240); TRRD(l3, b_ + 12288); TRRD(h3, b_ + 14336); \
        asm volatile("s_waitcnt lgkmcnt(0)" ::: "memory"); SBAR(); \
        o[d0] = __builtin_amdgcn_mfma_f32_32x32x16_bf16(pa0, (bf16x8){l0[0], l0[1], l0[2], l0[3], h0[0], h0[1], h0[2], h0[3]}, o[d0], 0, 0, 0); \
        o[d0] = __builtin_amdgcn_mfma_f32_32x32x16_bf16(pa1, (bf16x8){l1[0], l1[1], l1[2], l1[3], h1[0], h1[1], h1[2], h1[3]}, o[d0], 0, 0, 0); \
        o[d0] = __builtin_amdgcn_mfma_f32_32x32x16_bf16(pa2, (bf16x8){l2[0], l2[1], l2[2], l2[3], h2[0], h2[1], h2[2], h2[3]}, o[d0], 0, 0, 0); \
        o[d0] = __builtin_amdgcn_mfma_f32_32x32x16_bf16(pa3, (bf16x8){l3[0], l3[1], l3[2], l3[3], h3[0], h3[1], h3[2], h3[3]}, o[d0], 0, 0, 0); } while (0)
    PV_D0(0); PV_D0(1); PV_D0(2); PV_D0(3);
#undef PV_D0
#undef TRRD
}
__device__ __forceinline__ void pack_p(const f32x16& p0, const f32x16& p1, bf16x8& pa0, bf16x8& pa1, bf16x8& pa2, bf16x8& pa3) {
#define PK4(P, B_, OUT) do { unsigned a0 = cvt_pk_bf16(P[B_+0], P[B_+1]), a1 = cvt_pk_bf16(P[B_+2], P[B_+3]); \
        unsigned b0 = cvt_pk_bf16(P[B_+4], P[B_+5]), b1 = cvt_pk_bf16(P[B_+6], P[B_+7]); \
        auto r0 = __builtin_amdgcn_permlane32_swap(a0, b0, false, false); auto r1 = __builtin_amdgcn_permlane32_swap(a1, b1, false, false); \
        u32x4 w = {r0[0], r1[0], r0[1], r1[1]}; OUT = __builtin_bit_cast(bf16x8, w); } while (0)
    PK4(p0, 0, pa0); PK4(p0, 8, pa1); PK4(p1, 0, pa2); PK4(p1, 8, pa3);
#undef PK4
}
__device__ __forceinline__ void swap32(float x, float& lo, float& hi) {
    auto rr = __builtin_amdgcn_permlane32_swap(__float_as_uint(x), __float_as_uint(x), false, false); lo = __uint_as_float(rr[0]); hi = __uint_as_float(rr[1]);
}

struct UnitDesc {
    const bf16* Q;
    const bf16* Kn; const bf16* Vn;
    const float* Kc; const float* Vc;
    int cpitch, npast;
    const float* cum; int cstride;
    bf16* O;
    int P0, nq, nk;
    float kmax;
};

template <int MODE, bool SAMPLE>
__device__ __forceinline__ void unit(LAS char* lds, const UnitDesc& D) {
    constexpr int TPS = 1, NSLOT = 2 * TPS;
    const int tid = otid(), wid = __builtin_amdgcn_readfirstlane(tid >> 6), lane = tid & 63, r32 = lane & 31, hi = lane >> 5;
    LAS char* V_lds = lds + L_V; LAS char* K_lds = lds + L_K; LAS float* bias_l = (LAS float*)(lds + L_BIAS);
    LAS float* ws = (LAS float*)(lds + L_WS) + wid * 64; LAS unsigned* flag = (LAS unsigned*)(lds + L_FLAG);
    const int sr = tid >> 4, sc = (tid & 15) * 8, vst0 = v_st(sr, sc), vst1 = v_st(32 + sr, sc), kws = KSWZ(sr, sc * 2);
    const unsigned vb0 = (unsigned)(uintptr_t)V_lds + v_rd_base(lane);
    const bool wact = wid * 32 < D.nq;
    int qrow = wid * 32 + r32; if (qrow >= D.nq) qrow = D.nq - 1;
    const int wmin = D.P0 + wid * 32, wmax = D.P0 + (wid * 32 + 31 < D.nq ? wid * 32 + 31 : D.nq - 1);
    const int pos = D.P0 + qrow;
    bf16x8 qr[8];
#pragma unroll
    for (int d0 = 0; d0 < 8; ++d0) qr[d0] = *(const bf16x8*)(D.Q + (size_t)qrow * DM + d0 * 16 + hi * 8);
    const int jt_hi = (D.P0 + D.nq - 1) >> 6, NTL = jt_hi + 1;
    float ck_ref = 0.f; if (MODE == 0) ck_ref = D.cum[(size_t)D.P0 * D.cstride];
    static_assert(PAST % 64 == 0 && DECS <= 64, "sample units: the newest tile holds exactly this launch's tokens");
    bf16x8 st_k0[TPS], st_k1[TPS], st_v0[TPS], st_v1[TPS]; float st_b[TPS];
    f32x4 sf_k[4], sf_v[4];
#define LOADG(i, jt_) do { const int k0_ = (jt_) * 64; \
        if constexpr (SAMPLE) { const float* pk_ = D.Kc + (size_t)(k0_ + sr) * D.cpitch + sc; const float* pv_ = D.Vc + (size_t)(k0_ + sr) * D.cpitch + sc; \
            sf_k[0] = *(const f32x4*)pk_; sf_k[1] = *(const f32x4*)(pk_ + 4); sf_k[2] = *(const f32x4*)(pk_ + (size_t)32 * D.cpitch); sf_k[3] = *(const f32x4*)(pk_ + (size_t)32 * D.cpitch + 4); \
            sf_v[0] = *(const f32x4*)pv_; sf_v[1] = *(const f32x4*)(pv_ + 4); sf_v[2] = *(const f32x4*)(pv_ + (size_t)32 * D.cpitch); sf_v[3] = *(const f32x4*)(pv_ + (size_t)32 * D.cpitch + 4); \
        } else { \
            st_k0[i] = *(const bf16x8*)(D.Kn + (size_t)(k0_ + sr) * DM + sc); st_k1[i] = *(const bf16x8*)(D.Kn + (size_t)(k0_ + 32 + sr) * DM + sc); \
            st_v0[i] = *(const bf16x8*)(D.Vn + (size_t)(k0_ + sr) * DM + sc); st_v1[i] = *(const bf16x8*)(D.Vn + (size_t)(k0_ + 32 + sr) * DM + sc); } \
        if (MODE == 0 && tid < 64) { const int kk_ = k0_ + tid; st_b[i] = D.cum[(size_t)(kk_ < D.nk ? kk_ : D.nk - 1) * D.cstride]; } } while (0)
#define WRITEL(i, slot_, cvt_) do { const int so_ = (slot_) * SHM; \
        if (SAMPLE && (cvt_)) { st_k0[i] = pack8(sf_k[0], sf_k[1]); st_k1[i] = pack8(sf_k[2], sf_k[3]); st_v0[i] = pack8(sf_v[0], sf_v[1]); st_v1[i] = pack8(sf_v[2], sf_v[3]); } \
        *(LAS bf16x8*)(K_lds + so_ + kws) = st_k0[i]; *(LAS bf16x8*)(K_lds + so_ + kws + 32 * 256) = st_k1[i]; \
        *(LAS bf16x8*)(V_lds + so_ + vst0) = st_v0[i]; *(LAS bf16x8*)(V_lds + so_ + vst1) = st_v1[i]; \
        if (MODE == 0 && tid < 64) bias_l[(slot_) * 64 + tid] = (ck_ref - st_b[i]) * RSCALE; } while (0)
    f32x16 o[4];
#pragma unroll
    for (int d = 0; d < 4; ++d)
#pragma unroll
        for (int r = 0; r < 16; ++r) o[d][r] = 0.f;
    float m_reg = -1e30f, l_reg = 0.f, R = 1.f;
    float qk_bound = 0.f;
    if (MODE == 0) { float s = 0.f;
#pragma unroll
        for (int d0 = 0; d0 < 8; ++d0)
#pragma unroll
            for (int e = 0; e < 8; ++e) { const float v = __uint_as_float(((unsigned)(unsigned short)qr[d0][e]) << 16); s += v * v; }
        float a, b; swap32(s, a, b); qk_bound = __builtin_sqrtf(a + b) * D.kmax * 1.0001f; }
    bool wdone = !wact;
    auto compute = [&](int t, int slot) {
        const int jt = jt_hi - t, kb_ = jt * 64;
        const bool need = wact && (MODE == 0 ? kb_ <= wmax : kb_ < wmax);
        if (!need || wdone) return;
        const bool domask = MODE == 0 ? (kb_ + 63 > wmin) : (kb_ + 63 >= wmin);
        const int dq = pos - kb_ - 4 * hi - (MODE == 1 ? 1 : 0);
        f32x16 p0, p1;
        if (MODE == 0) {
            LAS const float* bl = bias_l + slot * 64 + 4 * hi;
#pragma unroll
            for (int g = 0; g < 4; ++g) { const f32x4 b0 = *(LAS const f32x4*)(bl + 8 * g), b1 = *(LAS const f32x4*)(bl + 32 + 8 * g);
#pragma unroll
                for (int e = 0; e < 4; ++e) { p0[4 * g + e] = b0[e]; p1[4 * g + e] = b1[e]; } }
        } else {
#pragma unroll
            for (int r = 0; r < 16; ++r) { p0[r] = 0.f; p1[r] = 0.f; }
        }
        SBAR(); qkt(p0, p1, K_lds + slot * SHM, r32, hi, qr); SBAR();
        bf16x8 pa0, pa1, pa2, pa3;
        if (MODE == 0) {
            const float NEG = -__builtin_inff();
            if (domask) {
#pragma unroll
                for (int r = 0; r < 16; ++r) { const int c = (r & 3) + 8 * (r >> 2); if (dq - c < 0) p0[r] = NEG; if (dq - c - 32 < 0) p1[r] = NEG; }
            }
            float pmax = p0[0];
#pragma unroll
            for (int r = 1; r < 16; ++r) pmax = fmaxf(pmax, p0[r]);
#pragma unroll
            for (int r = 0; r < 16; ++r) pmax = fmaxf(pmax, p1[r]);
            { float a, b; swap32(pmax, a, b); pmax = fmaxf(a, b); }
            constexpr float C2 = SCALE * LOG2E;
            const float mn = fmaxf(m_reg, pmax), alpha = fexp2((m_reg - mn) * C2), mnL = -mn * C2; m_reg = mn;
            float ps = 0.f;
#pragma unroll
            for (int r = 0; r < 16; ++r) { p0[r] = fexp2(fmaf(p0[r], C2, mnL)); p1[r] = fexp2(fmaf(p1[r], C2, mnL)); ps += p0[r] + p1[r]; }
            { float a, b; swap32(ps, a, b); ps = a + b; }
            l_reg = l_reg * alpha + ps;
            if (__any(alpha < 1.f)) { if (hi == 0) ws[r32] = alpha; asm volatile("s_waitcnt lgkmcnt(0)" ::: "memory");
#pragma unroll
                for (int d_ = 0; d_ < 4; ++d_)
#pragma unroll
                    for (int r = 0; r < 16; ++r) o[d_][r] *= ws[crow(r, hi)];
                asm volatile("s_waitcnt lgkmcnt(0)" ::: "memory"); }
            wdone = D.kmax > 0.f && __all((qk_bound + bias_l[slot * 64] - m_reg) * C2 < -128.f);
        } else {
            constexpr float CZ = SCALE * LOG2E;
            f32x16 s0, s1;
#pragma unroll
            for (int r = 0; r < 16; ++r) {
                { const float e = fexp2(fminf(p0[r] * CZ, 126.f)), rr = __builtin_amdgcn_rcpf(1.f + e); s0[r] = rr; p0[r] = e * rr; }
                { const float e = fexp2(fminf(p1[r] * CZ, 126.f)), rr = __builtin_amdgcn_rcpf(1.f + e); s1[r] = rr; p1[r] = e * rr; }
            }
            if (domask) {
#pragma unroll
                for (int r = 0; r < 16; ++r) { const int c = (r & 3) + 8 * (r >> 2);
                    if (dq - c < 0) { s0[r] = 1.f; p0[r] = 0.f; } if (dq - c - 32 < 0) { s1[r] = 1.f; p1[r] = 0.f; } }
            }
            float glo[8], ghi[8];
#pragma unroll
            for (int g = 0; g < 4; ++g) { swap32((s0[4 * g] * s0[4 * g + 1]) * (s0[4 * g + 2] * s0[4 * g + 3]), glo[g], ghi[g]);
                                          swap32((s1[4 * g] * s1[4 * g + 1]) * (s1[4 * g + 2] * s1[4 * g + 3]), glo[4 + g], ghi[4 + g]); }
            float T = R;
#pragma unroll
            for (int m = 7; m >= 0; --m) {
                float run = hi ? T : T * ghi[m];
                if (m < 4) {
#pragma unroll
                    for (int e = 3; e >= 0; --e) { const float a = p0[4 * m + e] * run; run *= s0[4 * m + e]; p0[4 * m + e] = a; }
                } else {
#pragma unroll
                    for (int e = 3; e >= 0; --e) { const float a = p1[4 * (m - 4) + e] * run; run *= s1[4 * (m - 4) + e]; p1[4 * (m - 4) + e] = a; }
                }
                T *= glo[m] * ghi[m];
            }
            R = T;
            wdone = __all(R == 0.f);
        }
        pack_p(p0, p1, pa0, pa1, pa2, pa3);
        SBAR(); pv_tile(o, vb0 + slot * SHM, pa0, pa1, pa2, pa3); SBAR();
    };
#pragma unroll
    for (int i = 0; i < TPS; ++i) if (i < NTL) {
        if constexpr (SAMPLE) { const int ka = jt_hi * 64 + sr, kb = ka + 32; const bf16x8 z = (bf16x8){0, 0, 0, 0, 0, 0, 0, 0};
            st_k0[0] = ka < D.nk ? *(const bf16x8*)(D.Kn + (size_t)(ka - D.npast) * DM + sc) : z; st_v0[0] = ka < D.nk ? *(const bf16x8*)(D.Vn + (size_t)(ka - D.npast) * DM + sc) : z;
            st_k1[0] = kb < D.nk ? *(const bf16x8*)(D.Kn + (size_t)(kb - D.npast) * DM + sc) : z; st_v1[0] = kb < D.nk ? *(const bf16x8*)(D.Vn + (size_t)(kb - D.npast) * DM + sc) : z;
            if (MODE == 0 && tid < 64) { const int kk = jt_hi * 64 + tid; st_b[0] = D.cum[(size_t)(kk < D.nk ? kk : D.nk - 1) * D.cstride]; }
        } else LOADG(i, jt_hi - i); }
#pragma unroll
    for (int i = 0; i < TPS; ++i) if (i < NTL) WRITEL(i, i, false);
    __syncthreads();
#pragma unroll
    for (int i = 0; i < TPS; ++i) if (TPS + i < NTL) LOADG(i, jt_hi - TPS - i);
    int stg = 0;
    for (int t0 = 0; t0 < NTL; t0 += TPS, ++stg) {
#pragma unroll
        for (int i = 0; i < TPS; ++i) if (t0 + i < NTL) compute(t0 + i, (t0 + i) & (NSLOT - 1));
#pragma unroll
        for (int i = 0; i < TPS; ++i) if (t0 + TPS + i < NTL) WRITEL(i, (t0 + TPS + i) & (NSLOT - 1), true);
        if (lane == 0) flag[(stg & 1) * 8 + wid] = wdone ? 1u : 0u;
        __syncthreads();
        {
            unsigned all = 1u;
#pragma unroll
            for (int w = 0; w < 8; ++w) all &= flag[(stg & 1) * 8 + w];
            if (all) break;
        }
#pragma unroll
        for (int i = 0; i < TPS; ++i) if (t0 + 2 * TPS + i < NTL) LOADG(i, jt_hi - (t0 + 2 * TPS + i));
    }
#undef LOADG
#undef WRITEL
    if (wact) {
        float rli[16];
        if (MODE == 0) { if (hi == 0) ws[32 + r32] = l_reg; asm volatile("s_waitcnt lgkmcnt(0)" ::: "memory");
#pragma unroll
            for (int r = 0; r < 16; ++r) rli[r] = __builtin_amdgcn_rcpf(ws[32 + crow(r, hi)]); }
        bf16* Ow = D.O + (size_t)(wid * 32) * DM;
#pragma unroll
        for (int r = 0; r < 16; ++r) { const int orow = crow(r, hi);
#pragma unroll
            for (int d0 = 0; d0 < 4; ++d0) { const float v = MODE == 0 ? o[d0][r] * rli[r] : o[d0][r];
                const float vn = __shfl_xor(v, 1);
                if ((r32 & 1) == 0 && wid * 32 + orow < D.nq) *(unsigned*)(Ow + (size_t)orow * DM + d0 * 32 + r32) = cvt_pk_bf16(v, vn); } }
    }
    __syncthreads();
}

__device__ __forceinline__ void fox_sample_unit(LAS char* lds, const UnitDesc& D) {
    const int tid = otid(), wid = __builtin_amdgcn_readfirstlane(tid >> 6), lane = tid & 63, r32 = lane & 31, hi = lane >> 5;
    LAS char* Vw = lds + wid * 8192;
    LAS float* comb = (LAS float*)(lds + 65536);
    LAS float* ml = (LAS float*)(lds + L_BIAS);
    LAS float* ws = (LAS float*)(lds + L_WS) + wid * 64;
    const unsigned vb0 = (unsigned)(uintptr_t)Vw + v_rd_base(lane);
    const int qrow = r32 < D.nq ? r32 : D.nq - 1, pos = D.P0 + qrow;
    LAS char* Qs = lds + LDSCTL_OFF + 5120;
    if (tid < 256) { const int qr_ = tid >> 4, qc_ = tid & 15; const int qsrc = qr_ < D.nq ? qr_ : D.nq - 1;
        *(LAS bf16x8*)(Qs + qr_ * 272 + qc_ * 16) = *(const bf16x8*)(D.Q + (size_t)qsrc * DM + qc_ * 8); }
    __syncthreads();
    LAS const char* qsl = Qs + qrow * 272 + hi * 16;
    float qk_bound;
    { float s = 0.f;
#pragma unroll
      for (int d0 = 0; d0 < 8; ++d0) { const bf16x8 q_ = *(LAS const bf16x8*)(qsl + d0 * 32);
#pragma unroll
          for (int e = 0; e < 8; ++e) { const float v = __uint_as_float(((unsigned)(unsigned short)q_[e]) << 16); s += v * v; } }
      float a, b; swap32(s, a, b); qk_bound = __builtin_sqrtf(a + b) * D.kmax * 1.0001f; }
    const float ck_ref = D.cum[(size_t)D.P0 * D.cstride];
    const int NT32 = (D.nk + 31) >> 5;
    f32x16 o[4];
#pragma unroll
    for (int d = 0; d < 4; ++d)
#pragma unroll
        for (int r = 0; r < 16; ++r) o[d][r] = 0.f;
    float m_reg = -1e30f, l_reg = 0.f;
    constexpr float C2 = SCALE * LOG2E;
    const int vkey = lane >> 1, vcol = (lane & 1) * 64;
    for (int jt = NT32 - 1 - wid; jt >= 0; jt -= 8) {
        const int k0 = jt * 32;
        bf16x8 kf[8];
        const int kmy = k0 + r32;
        const float bmy = kmy < D.nk ? (ck_ref - D.cum[(size_t)kmy * D.cstride]) * RSCALE : 0.f;
        const float bnx = jt >= 8 ? (ck_ref - D.cum[(size_t)(k0 - 7 * 32 - 1) * D.cstride]) * RSCALE : 0.f;
        if (k0 >= D.npast) {
            const int kk = k0 + r32 - D.npast; const bf16x8 z = (bf16x8){0, 0, 0, 0, 0, 0, 0, 0};
#pragma unroll
            for (int d0 = 0; d0 < 8; ++d0) kf[d0] = k0 + r32 < D.nk ? *(const bf16x8*)(D.Kn + (size_t)kk * DM + d0 * 16 + hi * 8) : z;
            const int kv = k0 + vkey - D.npast;
#pragma unroll
            for (int j = 0; j < 8; ++j) { const bf16x8 v = k0 + vkey < D.nk ? *(const bf16x8*)(D.Vn + (size_t)kv * DM + vcol + j * 8) : z;
                *(LAS bf16x8*)(Vw + v_st(vkey, vcol + j * 8)) = v; }
        } else {
            const float* kp = D.Kc + (size_t)(k0 + r32) * D.cpitch + hi * 8; const float* vp = D.Vc + (size_t)(k0 + vkey) * D.cpitch + vcol;
            f32x4 kr[16], va[8], vb[8];
#pragma unroll
            for (int d0 = 0; d0 < 8; ++d0) { kr[2 * d0] = *(const f32x4*)(kp + d0 * 16); kr[2 * d0 + 1] = *(const f32x4*)(kp + d0 * 16 + 4); }
#pragma unroll
            for (int j = 0; j < 8; ++j) va[j] = *(const f32x4*)(vp + j * 4);
#pragma unroll
            for (int d0 = 0; d0 < 8; ++d0) kf[d0] = pack8(kr[2 * d0], kr[2 * d0 + 1]);
            SBAR();
#pragma unroll
            for (int j = 0; j < 8; ++j) vb[j] = *(const f32x4*)(vp + 32 + j * 4);
#pragma unroll
            for (int j = 0; j < 4; ++j) *(LAS bf16x8*)(Vw + v_st(vkey, vcol + j * 8)) = pack8(va[2 * j], va[2 * j + 1]);
#pragma unroll
            for (int j = 0; j < 4; ++j) *(LAS bf16x8*)(Vw + v_st(vkey, vcol + 32 + j * 8)) = pack8(vb[2 * j], vb[2 * j + 1]);
        }
        f32x16 p0;
#pragma unroll
        for (int r = 0; r < 16; ++r) p0[r] = __shfl(bmy, crow(r, hi));
        SBAR();
#pragma unroll
        for (int d0 = 0; d0 < 8; ++d0) p0 = __builtin_amdgcn_mfma_f32_32x32x16_bf16(kf[d0], *(LAS const bf16x8*)(qsl + d0 * 32), p0, 0, 0, 0);
        SBAR();
        if (k0 + 31 > D.P0) {
            const int dq = pos - k0 - 4 * hi; const float NEG = -__builtin_inff();
#pragma unroll
            for (int r = 0; r < 16; ++r) { const int c = (r & 3) + 8 * (r >> 2); if (dq - c < 0) p0[r] = NEG; }
        }
        float pmax = p0[0];
#pragma unroll
        for (int r = 1; r < 16; ++r) pmax = fmaxf(pmax, p0[r]);
        { float a, b; swap32(pmax, a, b); pmax = fmaxf(a, b); }
        const float mn = fmaxf(m_reg, pmax), alpha = fexp2((m_reg - mn) * C2), mnL = -mn * C2; m_reg = mn;
        float ps = 0.f;
#pragma unroll
        for (int r = 0; r < 16; ++r) { p0[r] = fexp2(fmaf(p0[r], C2, mnL)); ps += p0[r]; }
        { float a, b; swap32(ps, a, b); ps = a + b; }
        l_reg = l_reg * alpha + ps;
        if (__any(alpha < 1.f)) { if (hi == 0) ws[r32] = alpha; asm volatile("s_waitcnt lgkmcnt(0)" ::: "memory");
#pragma unroll
            for (int d_ = 0; d_ < 4; ++d_)
#pragma unroll
                for (int r = 0; r < 16; ++r) o[d_][r] *= ws[crow(r, hi)];
            asm volatile("s_waitcnt lgkmcnt(0)" ::: "memory"); }
        bf16x8 pa0, pa1;
        {
#define PK4(P, B_, OUT) do { unsigned a0 = cvt_pk_bf16(P[B_+0], P[B_+1]), a1 = cvt_pk_bf16(P[B_+2], P[B_+3]); \
        unsigned b0 = cvt_pk_bf16(P[B_+4], P[B_+5]), b1 = cvt_pk_bf16(P[B_+6], P[B_+7]); \
        auto r0 = __builtin_amdgcn_permlane32_swap(a0, b0, false, false); auto r1 = __builtin_amdgcn_permlane32_swap(a1, b1, false, false); \
        u32x4 w = {r0[0], r1[0], r0[1], r1[1]}; OUT = __builtin_bit_cast(bf16x8, w); } while (0)
            PK4(p0, 0, pa0); PK4(p0, 8, pa1);
#undef PK4
        }
        SBAR();
#define TRRD(dst, off) asm volatile("ds_read_b64_tr_b16 %0, %1 offset:%2" : "=&v"(dst) : "v"(vb0), "i"(off) : "memory")
#define PV_D0(d0) do { s16x4 l0, l1, h0, h1; constexpr int b_ = v_rd_off(d0, 0, 0); \
        TRRD(l0, b_); TRRD(h0, b_ + 2048); TRRD(l1, b_ + 4096); TRRD(h1, b_ + 6144); \
        asm volatile("s_waitcnt lgkmcnt(0)" ::: "memory"); SBAR(); \
        o[d0] = __builtin_amdgcn_mfma_f32_32x32x16_bf16(pa0, (bf16x8){l0[0], l0[1], l0[2], l0[3], h0[0], h0[1], h0[2], h0[3]}, o[d0], 0, 0, 0); \
        o[d0] = __builtin_amdgcn_mfma_f32_32x32x16_bf16(pa1, (bf16x8){l1[0], l1[1], l1[2], l1[3], h1[0], h1[1], h1[2], h1[3]}, o[d0], 0, 0, 0); } while (0)
        PV_D0(0); PV_D0(1); PV_D0(2); PV_D0(3);
#undef PV_D0
#undef TRRD
        SBAR();
        if (D.kmax > 0.f && jt >= 8 && __all((qk_bound + bnx - m_reg) * C2 < -128.f)) break;
    }
    if (hi == 0 && r32 < 16) { ml[(wid * 16 + r32) * 2] = m_reg; ml[(wid * 16 + r32) * 2 + 1] = l_reg; }
#pragma unroll
    for (int r = 0; r < 8; ++r) { const int row = crow(r, hi);
#pragma unroll
        for (int d0 = 0; d0 < 4; ++d0) comb[(wid * 16 + row) * 128 + d0 * 32 + r32] = o[d0][r]; }
    __syncthreads();
    {
        const int row = tid >> 5, c4 = (tid & 31) * 4;
        float M = -1e30f;
#pragma unroll
        for (int w = 0; w < 8; ++w) M = fmaxf(M, ml[(w * 16 + row) * 2]);
        f32x4 num = {0.f, 0.f, 0.f, 0.f}; float den = 0.f;
#pragma unroll
        for (int w = 0; w < 8; ++w) { const float sc_ = fexp2((ml[(w * 16 + row) * 2] - M) * C2);
            den += sc_ * ml[(w * 16 + row) * 2 + 1]; num += *(LAS const f32x4*)(comb + (w * 16 + row) * 128 + c4) * sc_; }
        const float rd = 1.f / den;
        if (row < D.nq) { const u32x2 wv = {cvt_pk_bf16(num[0] * rd, num[1] * rd), cvt_pk_bf16(num[2] * rd, num[3] * rd)}; *(u32x2*)(D.O + (size_t)row * DM + c4) = wv; }
    }
    __syncthreads();
}
}

struct Args { const float* in[21]; float* out; unsigned char* ws; };

__device__ __forceinline__ u32x4 pk8(const float* v) { u32x4 w = {cvt_pk_bf16(v[0], v[1]), cvt_pk_bf16(v[2], v[3]), cvt_pk_bf16(v[4], v[5]), cvt_pk_bf16(v[6], v[7])}; return w; }

template <int RM, bool GAIN>
__device__ __forceinline__ void conv_item(LAS unsigned char* lw, const float* W, int ldn, const float* gain, bf16* WT, int K, int item, int nblk, int lane_) {
    int lane = lane_; asm volatile("" : "+v"(lane));
    const int kb = __builtin_amdgcn_readfirstlane(item / nblk), nb = __builtin_amdgcn_readfirstlane(item % nblk), k0 = kb * 64, n = nb * 64 + lane;
    const float* rowp = W + (size_t)k0 * ldn + nb * 64;
    float v[64];
#pragma unroll
    for (int i = 0; i < 64; ++i) { v[i] = __builtin_nontemporal_load(rowp + lane); rowp += ldn; }
    if (GAIN) { const unsigned gv = __float_as_uint(gain[k0 + lane]);
#pragma unroll
        for (int i = 0; i < 64; ++i) v[i] *= __uint_as_float(__builtin_amdgcn_readlane(gv, i)); }
#pragma unroll
    for (int j = 0; j < 8; ++j) *(LAS u32x4*)(lw + lane * 144 + j * 16) = pk8(v + j * 8);
    const int ch = lane & 7;
#pragma unroll
    for (int i = 0; i < 8; ++i) { const int rn = i * 8 + (lane >> 3), nn = nb * 64 + rn;
        const int row = RM == 0 ? nn : ((nn >> 7) * 256 + (nn & 127) + (RM == 2 ? 128 : 0));
        *(u32x4*)(WT + (size_t)row * K + k0 + ch * 8) = *(LAS const u32x4*)(lw + rn * 144 + ch * 16); }
}

#define CAS __attribute__((address_space(4)))
__device__ __forceinline__ const void* karg(int i) { const CAS char* p = (const CAS char*)__builtin_amdgcn_kernarg_segment_ptr(); asm volatile("" : "+s"(p));
    const GAS void* g = (const GAS void*)*(const CAS unsigned long long*)(p + 8 * i); return (const void*)g; }
#define KIN(i) ((const float*)karg(i))
#define KOUT ((float*)karg(21))
#define KWS ((unsigned char*)karg(22))

struct MapF { const bf16* XB; const bf16* WF; __device__ void get(int t, const bf16*& a, const bf16*& b0, const bf16*& b1) const { a = XB + (size_t)t * 128 * DM; b0 = WF; b1 = WF; } };
struct EpiF { static constexpr bool TWO_STAGE = false; const float* ssq; const float* b_f; float* LF; float* o_p; float* o_s;
            __device__ void operator()(int t, int r, int c4, f32x4 v0, f32x4) const { if (c4 >= 8) return; const int row = t * 128 + r; const float rs = rs_of(ssq, row);
                f32x4 lf;
#pragma unroll
                for (int e = 0; e < 4; ++e) { const float z = v0[e] * rs + b_f[c4 + e]; lf[e] = fminf(z, 0.f) - __logf(1.f + __expf(-fabsf(z))); }
                *(f32x4*)(LF + (size_t)row * 8 + c4) = lf;
                if (row < SEQ) *(f32x4*)(o_p + (size_t)row * 8 + c4) = lf; else *(f32x4*)(o_s + (size_t)(row - SEQ) * 8 + c4) = lf; } };
struct MapS { const bf16* A; const bf16* W; __device__ void get(int t, const bf16*& a, const bf16*& b0, const bf16*& b1) const { a = A; b0 = W + (size_t)t * 16 * DM; b1 = b0; } };
struct EpiS { static constexpr bool TWO_STAGE = false; const float* ssq; float* U; bf16* QB; bf16* KB; bf16* VB; float* fk; float* fv;
            __device__ void operator()(int t, int r, int c4, f32x4 v0, f32x4) const { const int row = SEQ + r, col = t * 16 + c4, sec = col >> 10, c = col & 1023; const f32x4 v = v0 * rs_of(ssq, row);
                const u32x2 w = {cvt_pk_bf16(v[0], v[1]), cvt_pk_bf16(v[2], v[3])};
                if (sec == 0) *(f32x4*)(U + (size_t)row * PW + c) = v;
                else if (sec == 1) *(u32x2*)(QB + (size_t)row * DM + c) = w;
                else if (sec == 2) { *(f32x4*)(fk + (size_t)r * FW + c) = v; *(u32x2*)(KB + (size_t)row * DM + c) = w; }
                else { *(f32x4*)(fv + (size_t)r * FW + c) = v; *(u32x2*)(VB + (size_t)row * DM + c) = w; } } };
struct MapP { const bf16* A; const bf16* W; __device__ void get(int t, const bf16*& a, const bf16*& b0, const bf16*& b1) const { a = A + (t >> 4) * 256; b0 = W + (size_t)t * 16 * 256; b1 = b0; } };
struct EpiP { static constexpr bool TWO_STAGE = false; const float* pscale; bf16* CAT;
            __device__ void operator()(int t, int r, int c4, f32x4 v0, f32x4) const { const int col = t * 16 + c4; const f32x4 v = v0 * *(const f32x4*)(pscale + col);
                const u32x2 w = {cvt_pk_bf16(v[0], v[1]), cvt_pk_bf16(v[2], v[3])}; *(u32x2*)(CAT + (size_t)(SEQ + r) * DM + col) = w; } };
struct MapW { const bf16* A; const bf16* W; int K; __device__ void get(int t, const bf16*& a, const bf16*& b0, const bf16*& b1) const { a = A; b0 = W + (size_t)t * 16 * K; b1 = b0; } };
struct MapGU { const bf16* A; const bf16* W; __device__ void get(int t, const bf16*& a, const bf16*& b0, const bf16*& b1) const { a = A; b0 = W + ((size_t)(t >> 3) * 256 + (t & 7) * 16) * DM; b1 = b0 + (size_t)128 * DM; } };
__device__ __forceinline__ f32x4 ld_hilo4(const bf16* hi, const bf16* lo) { const s16x4 h = *(const s16x4*)hi; f32x4 r;
#pragma unroll
    for (int e = 0; e < 4; ++e) r[e] = bf2f(h[e]);
    if (RES_LO) { const s16x4 l = *(const s16x4*)lo;
#pragma unroll
        for (int e = 0; e < 4; ++e) r[e] += bf2f(l[e]); }
    return r; }
template <bool RESF32> struct EpiResS { static constexpr bool TWO_STAGE = false; const float* resf; bf16* HB; bf16* HL; float* ssq;
    __device__ void operator()(int t, int r, int c4, f32x4 v0, f32x4) const { const size_t o = (size_t)r * DM + t * 16 + c4;
        const f32x4 v = v0 + (RESF32 ? *(const f32x4*)(resf + o) : ld_hilo4(HB + o, HL + o));
        const u32x2 wh = {cvt_pk_bf16(v[0], v[1]), cvt_pk_bf16(v[2], v[3])}; *(u32x2*)(HB + o) = wh;
        const s16x4 hh = __builtin_bit_cast(s16x4, wh); f32x4 rr;
#pragma unroll
        for (int e = 0; e < 4; ++e) rr[e] = v[e] - bf2f(hh[e]);
        if (RES_LO) { const u32x2 wl = {cvt_pk_bf16(rr[0], rr[1]), cvt_pk_bf16(rr[2], rr[3])}; *(u32x2*)(HL + o) = wl; }
        float s = (v[0] * v[0] + v[1] * v[1]) + (v[2] * v[2] + v[3] * v[3]); s += __shfl_xor(s, 16); s += __shfl_xor(s, 32);
        if (c4 == 0) atomicAdd(ssq + r, s); } };
struct EpiResSFinal { static constexpr bool TWO_STAGE = true;
    const bf16* HB; const bf16* HL; float* Y; const float* lnf; float* ssq; unsigned* cnt; unsigned* tmo; unsigned need;
    __device__ f32x4 stage1(int t, int r, int c4, f32x4 v0) const { const size_t o = (size_t)r * DM + t * 16 + c4; const f32x4 v = v0 + ld_hilo4(HB + o, HL + o);
        float s = (v[0] * v[0] + v[1] * v[1]) + (v[2] * v[2] + v[3] * v[3]); s += __shfl_xor(s, 16); s += __shfl_xor(s, 32);
        if (c4 == 0) atomicAdd(ssq + r, s);
        return v; }
    __device__ void wait_all() const { asm volatile("s_waitcnt vmcnt(0)" ::: "memory"); __syncthreads(); if (threadIdx.x == 0) wait_count(cnt, need, tmo); __syncthreads(); }
    __device__ void stage2(int t, int r, int c4, f32x4 v) const { const size_t o = (size_t)r * DM + t * 16 + c4;
        const float rs = __builtin_amdgcn_rsqf(__hip_atomic_load(ssq + r, __ATOMIC_RELAXED, __HIP_MEMORY_SCOPE_AGENT) * (1.f / DM) + EPS);
        *(f32x4*)(Y + o) = v * rs * *(const f32x4*)(lnf + t * 16 + c4); } };
struct EpiGUS { static constexpr bool TWO_STAGE = false; const float* ssq; bf16* ACT;
        __device__ void operator()(int t, int r, int c4, f32x4 g, f32x4 u) const { const float rs = rs_of(ssq, r); f32x4 a;
#pragma unroll
            for (int e = 0; e < 4; ++e) a[e] = swiglu1(g[e] * rs, u[e] * rs);
            const u32x2 w = {cvt_pk_bf16(a[0], a[1]), cvt_pk_bf16(a[2], a[3])}; *(u32x2*)(ACT + (size_t)r * DFF + t * 16 + c4) = w; } };
struct EpiQS { static constexpr bool TWO_STAGE = false; const float* ssq; bf16* QB; bf16* KB; bf16* VB; float* sk; float* sv;
            __device__ void operator()(int t, int r, int c4, f32x4 v0, f32x4) const { const int row = SEQ + r, col = t * 16 + c4, sec = col >> 11, c = col & 2047; const f32x4 v = v0 * rs_of(ssq, row);
                const u32x2 w = {cvt_pk_bf16(v[0], v[1]), cvt_pk_bf16(v[2], v[3])};
                if (sec == 0) *(u32x2*)(QB + (size_t)row * DM + c) = w;
                else if (sec == 1) { *(f32x4*)(sk + (size_t)r * DM + c) = v; *(u32x2*)(KB + (size_t)row * DM + c) = w; }
                else { *(f32x4*)(sv + (size_t)r * DM + c) = v; *(u32x2*)(VB + (size_t)row * DM + c) = w; } } };

struct MapW2 { const bf16* A; const bf16* W; int K; __device__ void get(int t, const bf16*& a, const bf16*& b0, const bf16*& b1) const { a = A; b0 = W + (size_t)t * 32 * K; b1 = b0 + (size_t)16 * K; } };
template <class E> struct Epi2 { static constexpr bool TWO_STAGE = false; E e; __device__ void operator()(int t, int r, int c4, f32x4 v0, f32x4 v1) const { e(2 * t, r, c4, v0, v0); e(2 * t + 1, r, c4, v1, v1); } };

#define x_p KIN(0)
#define x_s KIN(1)
#define cache_pool KIN(2)
#define c_fk KIN(3)
#define c_fv KIN(4)
#define c_flf KIN(5)
#define c_sk KIN(6)
#define c_sv KIN(7)
#define ln_mix KIN(8)
#define w_in KIN(9)
#define b_f KIN(10)
#define w_pool KIN(11)
#define pscale KIN(12)
#define w_out0 KIN(13)
#define w_qkv KIN(14)
#define w_out1 KIN(15)
#define ln_ffn KIN(16)
#define w_gate KIN(17)
#define w_up KIN(18)
#define w_down KIN(19)
#define ln_final KIN(20)
#define out KOUT
#define WIN ((bf16*)(KWS + WS_WIN))
#define WF ((bf16*)(KWS + WS_WF))
#define WPOOL ((bf16*)(KWS + WS_WPOOL))
#define WOUT0 ((bf16*)(KWS + WS_WOUT0))
#define WGU0 ((bf16*)(KWS + WS_WGU0))
#define WDN0 ((bf16*)(KWS + WS_WDN0))
#define WQKV ((bf16*)(KWS + WS_WQKV))
#define WOUT1 ((bf16*)(KWS + WS_WOUT1))
#define WGU1 ((bf16*)(KWS + WS_WGU1))
#define WDN1 ((bf16*)(KWS + WS_WDN1))
#define XB ((bf16*)(KWS + WS_HB))
#define U ((float*)(KWS + WS_U))
#define UBF ((bf16*)(KWS + WS_U))
#define QB ((bf16*)(KWS + WS_QB))
#define KB ((bf16*)(KWS + WS_KB))
#define VB ((bf16*)(KWS + WS_VB))
#define DBF ((bf16*)(KWS + WS_DB))
#define CAT ((bf16*)(KWS + WS_CAT))
#define HL ((bf16*)(KWS + WS_H))
#define HB ((bf16*)(KWS + WS_HB))
#define ACT ((bf16*)(KWS + WS_ACT))
#define LF ((float*)(KWS + WS_LF))
#define CUMP ((float*)(KWS + WS_CUMP))
#define CUMS ((float*)(KWS + WS_CUMS))
#define ssq ((float*)(KWS + WS_CTL) + CW_SSQ)
#define SCRH ((float*)(KWS + WS_SCRH))
#define SCRHB ((bf16*)(KWS + WS_SCRHB))
template <int Q>
__device__ __forceinline__ void drain_queue(LAS unsigned char* lds, volatile LAS unsigned* MISC, gu32* ctl, int tid, int wave, int lane) {
    constexpr int I_SQ = (DM / 64) * (DM / 64), I_FF = (DM / 64) * (DFF / 64), I_QKV = (DM / 64) * (3 * DM / 64);
    constexpr int TOT = Q == 0 ? I_SQ + 3 * I_FF : (Q == 1 ? I_FF + I_QKV + I_SQ : I_FF);
    unsigned* qh = (unsigned*)(ctl + CW_QHEAD + 64 * Q);
    __syncthreads();
    for (int par = 0;; par ^= 1) {
        if (tid == 0) MISC[16 + par] = __hip_atomic_fetch_add(qh, 8u, __ATOMIC_RELAXED, __HIP_MEMORY_SCOPE_AGENT);
        __syncthreads();
        const int base = (int)MISC[16 + par];
        if (base >= TOT) break;
        int it_ = base + wave; bool done_ = it_ >= TOT;
#define DCONV(RM, GN, W, ldn, N, gain, WT, K) if (!done_) { const int nblk = (N) / 64, nit = ((K) / 64) * nblk; if (it_ < nit) { conv_item<RM, GN>(lds + wave * 9216, W, ldn, gain, WT, K, it_, nblk, lane); done_ = true; } else it_ -= nit; }
        if constexpr (Q == 0) {
            DCONV(0, false, w_out0, DM, DM, nullptr, WOUT0, DM)
            DCONV(1, true, w_gate, DFF, DFF, ln_ffn, WGU0, DM)
            DCONV(2, true, w_up, DFF, DFF, ln_ffn, WGU0, DM)
            DCONV(1, true, w_gate + (size_t)DM * DFF, DFF, DFF, ln_ffn + DM, WGU1, DM)
        } else if constexpr (Q == 1) {
            DCONV(0, false, w_down, DM, DM, nullptr, WDN0, DFF)
            DCONV(0, true, w_qkv, 3 * DM, 3 * DM, ln_mix + DM, WQKV, DM)
            DCONV(0, false, w_out1, DM, DM, nullptr, WOUT1, DM)
        } else if constexpr (Q == 3) {
            DCONV(2, true, w_up + (size_t)DM * DFF, DFF, DFF, ln_ffn + DM, WGU1, DM)
        } else {
            DCONV(0, false, w_down + (size_t)DFF * DM, DM, DM, nullptr, WDN1, DFF)
        }
#undef DCONV
    }
}
__global__ void __launch_bounds__(NT, 2) fwd(Args args) {
    extern __shared__ __attribute__((aligned(16))) unsigned char lds_raw[];
    LAS unsigned char* lds = (LAS unsigned char*)lds_raw;
    volatile LAS unsigned* MISC = (volatile LAS unsigned*)(lds + MISC_OFF);
    const int tid = otid(), lane = tid & 63, wave = __builtin_amdgcn_readfirstlane(tid >> 6);
    const int G = gridDim.x, bx = blockIdx.x;
    const int vcu = (G % 8 == 0) ? (bx % 8) * (G / 8) + bx / 8 : bx;
    gu32* ctl = (gu32*)(KWS + WS_CTL);
    for (int u = tid; u < (LDS_BYTES - LDSCTL_OFF) / 4; u += NT) ((LAS unsigned*)(lds + LDSCTL_OFF))[u] = 0u;
    __syncthreads();
    XcdBarrier bar = xcd_barrier_post((unsigned*)(ctl + CW_BAR), MISC + 8);

    const int gw = vcu * NWAVES + wave, NGW = G * NWAVES;

    REP(0) {
        int it = gw;
#define CONV(RM, GN, W, ldn, N, gain, WT, K) { const int nblk = (N) / 64, nit = ((K) / 64) * nblk; const float* W_ = W; const float* g_ = gain; bf16* WT_ = WT; for (; it < nit; it += NGW) conv_item<RM, GN>(lds + wave * 9216, W_, ldn, g_, WT_, K, it, nblk, lane); it -= nit; }
        CONV(0, true, w_in, INAB, 4096, ln_mix, WIN, DM)
#pragma unroll 1
        for (int g = 0; g < 4; ++g) CONV(0, false, w_pool + (size_t)g * 65536, 256, 256, nullptr, WPOOL + (size_t)g * 65536, 256)
#undef CONV
        for (int i = bx * NT + tid; i < 16 * DM; i += G * NT) { const int j = i / DM, k = i % DM; const float v = j < 8 ? ln_mix[k] * w_in[(size_t)k * INAB + 4096 + j] : 0.f; WF[i] = (bf16)(cvt_pk_bf16(v, 0.f) & 0xffffu); }
        for (int m = gw; m < MP; m += NGW) {
            const float* xr = m < SEQ ? x_p + (size_t)m * DM : x_s + (size_t)(m - SEQ) * DM;
            f32x4 v[8]; float s = 0.f;
#pragma unroll
            for (int j = 0; j < 8; ++j) { v[j] = *(const f32x4*)(xr + (lane + 64 * j) * 4); s += (v[j][0] * v[j][0] + v[j][1] * v[j][1]) + (v[j][2] * v[j][2] + v[j][3] * v[j][3]); }
            s = wave_sum(s);
            if (lane == 0) ssq[m] = s;
#pragma unroll
            for (int j = 0; j < 8; ++j) { u32x2 w = {cvt_pk_bf16(v[j][0], v[j][1]), cvt_pk_bf16(v[j][2], v[j][3])}; *(u32x2*)(XB + (size_t)m * DM + (lane + 64 * j) * 4) = w; }
        }
    }
    {
        const int p = tid >> 1, hf = tid & 1, hd = p & 7, rofs = p >> 3;
        unsigned* kmx = (unsigned*)(ctl + CW_KMAX);
        const int NIT = DECB * PAST / 32, ipw = (NIT + G - 1) / G, i0 = bx * ipw, i1 = i0 + ipw < NIT ? i0 + ipw : NIT;
        float smax = 0.f; int bcur = -1;
        for (int it = i0; it < i1; ++it) {
            const int b = it / (PAST / 32);
            if (b != bcur && bcur >= 0) { wg_max8((LAS float*)lds, smax, lane, wave, tid, kmx + 8 + bcur * 8); smax = 0.f; }
            bcur = b;
            const int row = it * 32 + rofs; const float* kp = c_fk + (size_t)row * FW + hd * HD + hf * 64;
            f32x4 v[16]; float s = 0.f;
#pragma unroll
            for (int j = 0; j < 16; ++j) v[j] = *(const f32x4*)(kp + j * 4);
#pragma unroll
            for (int j = 0; j < 16; ++j) s += (v[j][0] * v[j][0] + v[j][1] * v[j][1]) + (v[j][2] * v[j][2] + v[j][3] * v[j][3]);
            s += __shfl_xor(s, 1); s = fmaxf(s, __shfl_xor(s, 16)); s = fmaxf(s, __shfl_xor(s, 32));
            smax = fmaxf(smax, s);
        }
        if (bcur >= 0) wg_max8((LAS float*)lds, smax, lane, wave, tid, kmx + 8 + bcur * 8);
    }
    xcd_barrier(bar);

    REP(1) {
        pg8::Gemm g{XB, WIN, DM, DM, DM, 0}; EpiIn E{ssq, UBF, out + O_POOLP, QB, KB, VB, out + O_FKP, out + O_FVP};
        pg8::BalancedOrder S{2, bx, G}; pg8::gemm_phase<EpiIn, pg8::BalancedOrder, true>(lds, g, S, E);
    }
    REP(2) {


        small_gemm<1>(lds, MP / 128, DM, DM, DM, MapF{XB, WF}, EpiF{ssq, b_f, LF, out + O_FLFP, out + O_FLFS}, G, (bx + G / 2) % G);
    }
    REP(2) {


        small_gemm<2>(lds, 128, DM, DM, DM, MapW2{XB + (size_t)SEQ * DM, WIN, DM}, Epi2<EpiS>{EpiS{ssq, U, QB, KB, VB, out + O_FKS, out + O_FVS}}, G, bx);
    }
    xcd_barrier(bar);

    REP(4) {
        const int c0 = 4 * (tid & 255), grp = __builtin_amdgcn_readfirstlane((tid >> 6) & 3), w = 2 << grp, hlf = __builtin_amdgcn_readfirstlane(tid >> 8);
        for (int pit = bx; pit < (512 + DECB) / 2; pit += G) {
            const int it = 2 * pit + hlf;
            const bool smp = it >= 512; const int b = it - 512;
            const int r0 = smp ? 0 : it * 16, base = smp ? SEQ + b * DECS : 0;
            const float* ub = U + (size_t)base * PW + c0;
            const float* pre = cache_pool + (size_t)(smp ? b : 0) * 15 * PW + c0;
            f32x4 a[31], u[16];
            if (smp) {
#pragma unroll
                for (int i = 0; i < 31; ++i) { const int j = i - 15;
                    if (j >= 0) a[i] = *(const f32x4*)(ub + (size_t)j * PW);
                    else a[i] = *(const f32x4*)(pre + (size_t)(15 + j) * PW); }
            } else {
                const bf16* ubb = UBF + c0; u32x2 ab[31];
#pragma unroll
                for (int i = 0; i < 31; ++i) { const int j = r0 - 15 + i; ab[i] = j >= 0 ? *(const u32x2*)(ubb + (size_t)j * PW) : (u32x2){0u, 0u}; }
#pragma unroll
                for (int i = 0; i < 31; ++i) a[i] = (f32x4){__uint_as_float(ab[i][0] << 16), __uint_as_float(ab[i][0] & 0xffff0000u), __uint_as_float(ab[i][1] << 16), __uint_as_float(ab[i][1] & 0xffff0000u)};
            }
#pragma unroll
            for (int k = 0; k < 16; ++k) u[k] = a[15 + k];
#pragma unroll
            for (int i = 30; i >= 1; --i) a[i] += a[i - 1];
            if (w >= 4) {
#pragma unroll
                for (int i = 30; i >= 3; --i) a[i] += a[i - 2]; }
            if (w >= 8) {
#pragma unroll
                for (int i = 30; i >= 7; --i) a[i] += a[i - 4]; }
            if (w >= 16) {
#pragma unroll
                for (int i = 30; i >= 15; --i) a[i] += a[i - 8]; }
#pragma unroll
            for (int k = 0; k < 16; ++k) { const int t = r0 + k;
                const float cnt = smp ? (float)w : (float)(t + 1 < w ? t + 1 : w);
                const f32x4 d = a[15 + k] * (1.f / cnt) - u[k];
                *(u32x2*)(DBF + (size_t)(base + t) * PW + c0) = (u32x2){cvt_pk_bf16(d[0], d[1]), cvt_pk_bf16(d[2], d[3])}; }
        }
        for (int i = bx * NT + tid; i < DECB * 15 * (PW / 4); i += G * NT) {
            const int q = i / (PW / 4), c4 = (i % (PW / 4)) * 4, b = q / 15, j = q % 15;
            *(f32x4*)(out + O_POOLS + (size_t)q * PW + c4) = *(const f32x4*)(U + (size_t)(SEQ + b * DECS + 1 + j) * PW + c4);
        }
        {
            const int p = tid >> 1, hf = tid & 1, hd = p & 7, rofs = p >> 3;
            unsigned* kmx = (unsigned*)(ctl + CW_KMAX);
            const int NSC = SEQ / 1024 + DECB * ((NKS + 1023) / 1024), GK = G > 2 * NSC ? G - NSC : G;
            for (int it = (G > 2 * NSC && bx >= GK) ? (1 << 30) : (bx + GK - 8) % GK; it < MP / 64; it += GK) {
                bf16x8 v[2][8];
#pragma unroll
                for (int r2 = 0; r2 < 2; ++r2) { const bf16* kp = KB + (size_t)(it * 64 + r2 * 32 + rofs) * DM + hd * HD + hf * 64;
#pragma unroll
                    for (int j = 0; j < 8; ++j) v[r2][j] = *(const bf16x8*)(kp + j * 8); }
                float sm[2];
#pragma unroll
                for (int r2 = 0; r2 < 2; ++r2) { float s = 0.f;
#pragma unroll
                    for (int j = 0; j < 8; ++j)
#pragma unroll
                        for (int e = 0; e < 8; ++e) { const float f = __uint_as_float(((unsigned)(unsigned short)v[r2][j][e]) << 16); s += f * f; }
                    s += __shfl_xor(s, 1); s = fmaxf(s, __shfl_xor(s, 16)); s = fmaxf(s, __shfl_xor(s, 32)); sm[r2] = s; }
                if (it * 64 < SEQ) wg_max8((LAS float*)lds, fmaxf(sm[0], sm[1]), lane, wave, tid, kmx);
                else {
#pragma unroll
                    for (int r2 = 0; r2 < 2; ++r2) { const int row = it * 64 + r2 * 32 + rofs;
                        if ((lane & 0x31) == 0) atomicMax(kmx + 8 + ((row - SEQ) / DECS) * 8 + hd, __float_as_uint(sm[r2])); } }
            }
            __syncthreads();
        }
        {
            constexpr int SPT = 2, SIT = NT * SPT, NIP = SEQ / SIT, NIS = (NKS + SIT - 1) / SIT, NPRE = (NIP > NIS ? NIP : NIS) - 1;
            LAS double* sc = (LAS double*)lds;
            for (int it = G - 1 - bx; it < NIP + DECB * NIS; it += G) {
                const bool smp = it >= NIP; const int b = smp ? (it - NIP) / NIS : 0, r = smp ? (it - NIP) % NIS : it, n = smp ? NKS : SEQ;
                f32x4 v[NPRE + 1][SPT][2];
#pragma unroll
                for (int q = 0; q <= NPRE; ++q) { const int rr = (q < NPRE && q < r) ? q : r;
#pragma unroll
                    for (int j = 0; j < SPT; ++j) { int p = rr * SIT + tid * SPT + j; p = p < n ? p : n - 1;
                        const float* rp = !smp ? LF + (size_t)p * 8 : (p < PAST ? c_flf + ((size_t)b * PAST + p) * FH : LF + (size_t)(SEQ + b * DECS + p - PAST) * 8);
                        v[q][j][0] = *(const f32x4*)rp; v[q][j][1] = *(const f32x4*)(rp + 4); } }
                __builtin_amdgcn_sched_barrier(0);
                double pre[8], run[8], loc[SPT][8];
#pragma unroll
                for (int e = 0; e < 8; ++e) { pre[e] = 0.0; run[e] = 0.0; }
#pragma unroll
                for (int q = 0; q < NPRE; ++q) if (q < r) {
#pragma unroll
                    for (int j = 0; j < SPT; ++j)
#pragma unroll
                        for (int e = 0; e < 8; ++e) pre[e] += (double)v[q][j][e >> 2][e & 3]; }
#pragma unroll
                for (int j = 0; j < SPT; ++j) { const bool ok = r * SIT + tid * SPT + j < n;
#pragma unroll
                    for (int e = 0; e < 8; ++e) { run[e] += ok ? (double)v[NPRE][j][e >> 2][e & 3] : 0.0; loc[j][e] = run[e]; } }
                LAS double* sT = (LAS double*)lds; LAS double* sP = sT + NT * 8; LAS double* sW = sP + NT * 8;
#pragma unroll
                for (int e = 0; e < 8; ++e) { sT[tid * 8 + e] = run[e]; sP[tid * 8 + e] = pre[e]; }
                __syncthreads();
                { const int e = tid & 7, seg = tid >> 3; double acc = 0.0, accp = 0.0, ex[8];
#pragma unroll
                    for (int k = 0; k < 8; ++k) { ex[k] = acc; acc += sT[(seg * 8 + k) * 8 + e]; accp += sP[(seg * 8 + k) * 8 + e]; }
                    double inc = acc;
#pragma unroll
                    for (int o = 8; o < 64; o <<= 1) { const double y = __shfl_up(inc, o); if (lane >= o) inc += y; accp += __shfl_xor(accp, o); }
                    if (lane >= 56) { sW[wave * 8 + e] = inc; sW[64 + wave * 8 + e] = accp; }
                    __syncthreads();
                    double base = inc - acc;
                    for (int k = 0; k < 8; ++k) { base += sW[64 + k * 8 + e]; if (k < wave) base += sW[k * 8 + e]; }
#pragma unroll
                    for (int k = 0; k < 8; ++k) sT[(seg * 8 + k) * 8 + e] = base + ex[k]; }
                __syncthreads();
#pragma unroll
                for (int j = 0; j < SPT; ++j) { const int p = r * SIT + tid * SPT + j;
                    if (p < n) { float* op = !smp ? CUMP + (size_t)p * 8 : CUMS + ((size_t)b * NKS + p) * 8; f32x4 o0, o1;
#pragma unroll
                        for (int e = 0; e < 4; ++e) { o0[e] = (float)(sT[tid * 8 + e] + loc[j][e]); o1[e] = (float)(sT[tid * 8 + 4 + e] + loc[j][4 + e]); }
                        *(f32x4*)op = o0; *(f32x4*)(op + 4) = o1; } }
                __syncthreads();
            }
        }
    }
    xcd_barrier(bar);

    REP(5) {
        pg8::Gemm g{DBF, WPOOL, PW, 256, 256, 256}; pg8::StaticOrder S; S.init(SEQ / 256, 4, G, bx);
        EpiPool E{pscale, CAT};
        pg8::gemm_phase<EpiPool, pg8::StaticOrder, true>(lds, g, S, E);
    }
    REP(5) {


        small_gemm<1>(lds, 64, PW, 256, 256, MapP{DBF + (size_t)SEQ * PW, WPOOL}, EpiP{pscale, CAT}, G, bx);
    }
    REP(7) {
        for (int uix = bx; uix < 256; uix += G) {
            att::UnitDesc D; const int h = uix & 7, qb = 31 - (uix >> 3);
            D.Q = QB + (size_t)qb * 256 * DM + h * HD; D.Kn = KB + h * HD; D.Vn = VB + h * HD; D.Kc = nullptr; D.Vc = nullptr; D.cpitch = 0; D.npast = 0;
            D.cum = CUMP + h; D.cstride = 8; D.O = CAT + (size_t)qb * 256 * DM + FW + h * HD; D.P0 = qb * 256; D.nq = 256; D.nk = qb * 256 + 256;
            D.kmax = __builtin_sqrtf(__uint_as_float(ctl[CW_KMAX + h]));
            att::unit<0, false>((LAS char*)lds, D);
        }
        for (int par = 0;; par ^= 1) {
            if (tid == 0) MISC[18 + par] = __hip_atomic_fetch_add((unsigned*)(ctl + CW_SHEAD) + (rep_ ? 64 : 0), 1u, __ATOMIC_RELAXED, __HIP_MEMORY_SCOPE_AGENT);
            __syncthreads();
            const int sx = (int)MISC[18 + par];
            if (sx >= DECB * FH) break;
            att::UnitDesc D; const int b = sx / FH, h = sx % FH;
            D.Q = QB + (size_t)(SEQ + b * DECS) * DM + h * HD; D.Kn = KB + (size_t)(SEQ + b * DECS) * DM + h * HD; D.Vn = VB + (size_t)(SEQ + b * DECS) * DM + h * HD;
            D.Kc = c_fk + (size_t)b * PAST * FW + h * HD; D.Vc = c_fv + (size_t)b * PAST * FW + h * HD; D.cpitch = FW; D.npast = PAST;
            D.cum = CUMS + (size_t)b * NKS * 8 + h; D.cstride = 8; D.O = CAT + (size_t)(SEQ + b * DECS) * DM + FW + h * HD; D.P0 = PAST; D.nq = DECS; D.nk = NKS;
            D.kmax = __builtin_sqrtf(__uint_as_float(ctl[CW_KMAX + 8 + b * 8 + h])) * 1.005f;
            att::fox_sample_unit((LAS char*)lds, D);
        }
    }
    drain_queue<0>(lds, MISC, ctl, tid, wave, lane);
    xcd_barrier(bar);


#define MLP_BLOCK(WOUT, WGU, WDN, RF32, RES_P, RES_S, SSQ_MID, SSQ_OUT, LAST) \
    {   pg8::Gemm g{CAT, WOUT, DM, DM, DM, 0}; pg8::StaticOrder S; S.init(SEQ / 256, DM / 256, G, bx); \
        EpiRes<RF32> E{RES_P, HB, HL, SSQ_MID}; pg8::gemm_phase<EpiRes<RF32>, pg8::StaticOrder, true>(lds, g, S, E); \
        small_gemm_t<1, 4>(lds, DM / 8, DM, DM, DM, MapW{CAT + (size_t)SEQ * DM, WOUT, DM}, EpiResS<RF32>{RES_S, HB + (size_t)SEQ * DM, HL + (size_t)SEQ * DM, SSQ_MID + SEQ}, G, bx); } \
    xcd_barrier(bar); \
    REP(9) {   pg8::Gemm g{HB, WGU, DM, DM, DM, 0}; pg8::StaticOrder S; S.init(MPAD / 256  , 2 * DFF / 256, G, bx); \
        EpiGU E{SSQ_MID, ACT}; pg8::gemm_phase<EpiGU, pg8::StaticOrder, true>(lds, g, S, E); } \
    if (LAST) drain_queue<2>(lds, MISC, ctl, tid, wave, lane); else drain_queue<1>(lds, MISC, ctl, tid, wave, lane); \
    xcd_barrier(bar); \
    if (LAST) {   \
        pg8::Gemm g{ACT, WDN, DFF, DFF, DFF, 0}; pg8::StaticOrder S; S.init(SEQ / 256, DM / 256, G, bx); \
        unsigned* fc_ = (unsigned*)(ctl + CW_FCNT); unsigned* tm_ = (unsigned*)(ctl + CW_TMO); \
        EpiResFinal E{HB, HL, out + O_YP, ln_final, SSQ_OUT, fc_, tm_}; pg8::gemm_phase<EpiResFinal, pg8::StaticOrder, false>(lds, g, S, E); \
        small_gemm_t<1, 4>(lds, DM / 8, DFF, DFF, DFF, MapW{ACT + (size_t)SEQ * DFF, WDN, DFF}, EpiResSFinal{HB + (size_t)SEQ * DM, HL + (size_t)SEQ * DM, out + O_YS, ln_final, SSQ_OUT + SEQ, fc_ + 64 * 32, tm_, (unsigned)(DM / 8)}, G, bx); \
    } else {   pg8::Gemm g{ACT, WDN, DFF, DFF, DFF, 0}; pg8::StaticOrder S; S.init(SEQ / 256, DM / 256, G, bx); \
        EpiRes<false> E{nullptr, HB, HL, SSQ_OUT}; pg8::gemm_phase<EpiRes<false>, pg8::StaticOrder, true>(lds, g, S, E); \
        small_gemm_t<1, 4>(lds, DM / 8, DFF, DFF, DFF, MapW{ACT + (size_t)SEQ * DFF, WDN, DFF}, EpiResS<false>{nullptr, HB + (size_t)SEQ * DM, HL + (size_t)SEQ * DM, SSQ_OUT + SEQ}, G, bx); } \
    if (!(LAST)) xcd_barrier(bar);

    MLP_BLOCK(WOUT0, WGU0, WDN0, false, nullptr, nullptr, ssq + MPAD, ssq + 2 * MPAD, false)

    REP(11) {
        pg8::Gemm g{HB, WQKV, DM, DM, DM, 0}; EpiQkv E{ssq + 2 * MPAD, QB, KB, VB, out + O_SKP, out + O_SVP};
        pg8::BalancedOrder S{3, bx, G}; pg8::gemm_phase<EpiQkv, pg8::BalancedOrder, true>(lds, g, S, E);

        small_gemm<2>(lds, 3 * DM / 32, DM, DM, DM, MapW2{HB + (size_t)SEQ * DM, WQKV, DM}, Epi2<EpiQS>{EpiQS{ssq + 2 * MPAD, QB, KB, VB, out + O_SKS, out + O_SVS}}, G, bx);
    }
    xcd_barrier(bar);

    REP(12) {
        for (int uix = bx; uix < 512 + DECB * SH; uix += G) {
            att::UnitDesc D;
            if (uix < 512) { const int h = uix & 15, q5 = (uix >> 4) & 15, qb = uix < 256 ? 31 - q5 : q5;
                D.Q = QB + (size_t)qb * 256 * DM + h * HD; D.Kn = KB + h * HD; D.Vn = VB + h * HD; D.Kc = nullptr; D.Vc = nullptr; D.cpitch = 0; D.npast = 0;
                D.cum = nullptr; D.cstride = 0; D.O = CAT + (size_t)qb * 256 * DM + h * HD; D.P0 = qb * 256; D.nq = 256; D.nk = qb * 256 + 256; D.kmax = 0.f;
                att::unit<1, false>((LAS char*)lds, D);
            } else { const int s = uix - 512, b = s / SH, h = s % SH;
                D.Q = QB + (size_t)(SEQ + b * DECS) * DM + h * HD; D.Kn = KB + (size_t)(SEQ + b * DECS) * DM + h * HD; D.Vn = VB + (size_t)(SEQ + b * DECS) * DM + h * HD;
                D.Kc = c_sk + (size_t)b * PAST * DM + h * HD; D.Vc = c_sv + (size_t)b * PAST * DM + h * HD; D.cpitch = DM; D.npast = PAST;
                D.cum = nullptr; D.cstride = 0; D.O = CAT + (size_t)(SEQ + b * DECS) * DM + h * HD; D.P0 = PAST; D.nq = DECS; D.nk = NKS; D.kmax = 0.f;
                att::unit<1, true>((LAS char*)lds, D);
            }
        }
    }
    drain_queue<3>(lds, MISC, ctl, tid, wave, lane);
    xcd_barrier(bar);

    MLP_BLOCK(WOUT1, WGU1, WDN1, false, nullptr, nullptr, ssq + 3 * MPAD, ssq + 4 * MPAD, true)

}

#undef x_p
#undef x_s
#undef cache_pool
#undef c_fk
#undef c_fv
#undef c_flf
#undef c_sk
#undef c_sv
#undef ln_mix
#undef w_in
#undef b_f
#undef w_pool
#undef pscale
#undef w_out0
#undef w_qkv
#undef w_out1
#undef ln_ffn
#undef w_gate
#undef w_up
#undef w_down
#undef ln_final
#undef out
#undef WIN
#undef WF
#undef WPOOL
#undef WOUT0
#undef WGU0
#undef WDN0
#undef WQKV
#undef WOUT1
#undef WGU1
#undef WDN1
#undef XB
#undef U
#undef UBF
#undef QB
#undef KB
#undef VB
#undef DBF
#undef CAT
#undef HL
#undef HB
#undef ACT
#undef LF
#undef CUMP
#undef CUMS
#undef ssq
#undef SCRH
#undef SCRHB
extern "C" void kernel_launch(void* const* d_in, const int* in_sizes, int n_in, void* d_out, int out_size, void* d_ws, size_t ws_size, hipStream_t stream) {
    static int grid = 0;
    if (grid == 0) {
        if (n_in != 21 || out_size != (int)O_END || ws_size < WS_END) { fprintf(stderr, "kernel_launch: unexpected shapes (n_in %d out %d ws %zu need %zu)\n", n_in, out_size, ws_size, (size_t)WS_END); grid = -1; return; }
        int dev = 0, cus = 0, per_cu = 0;
        if (hipGetDevice(&dev) != hipSuccess || hipDeviceGetAttribute(&cus, hipDeviceAttributeMultiprocessorCount, dev) != hipSuccess) { grid = -1; return; }
        if (hipFuncSetAttribute((const void*)fwd, hipFuncAttributeMaxDynamicSharedMemorySize, LDS_BYTES) != hipSuccess) { fprintf(stderr, "kernel_launch: hipFuncSetAttribute failed\n"); grid = -1; return; }
        if (hipOccupancyMaxActiveBlocksPerMultiprocessor(&per_cu, (const void*)fwd, NT, LDS_BYTES) != hipSuccess || per_cu < 1) { fprintf(stderr, "kernel_launch: occupancy query says %d\n", per_cu); }
        (void)hipGetLastError();
        grid = cus;
    }
    if (grid < 0) return;
    if (hipMemsetAsync((char*)d_ws + WS_CTL, 0, CTL_ZERO_BYTES, stream) != hipSuccess) return;
    Args a{};
    for (int i = 0; i < 21; ++i) a.in[i] = (const float*)d_in[i];
    a.out = (float*)d_out; a.ws = (unsigned char*)d_ws;
    hipLaunchKernelGGL(fwd, dim3(grid), dim3(NT), LDS_BYTES, stream, a);
}
```

```cpp
#include <hip/hip_runtime.h>
#include <cstdio>
#include <cstdint>

#define LAS __attribute__((address_space(3)))
#define GAS __attribute__((address_space(1)))
typedef unsigned short bf16;
typedef short bf16x8 __attribute__((ext_vector_type(8)));
typedef short s16x4 __attribute__((ext_vector_type(4)));
typedef float f32x4 __attribute__((ext_vector_type(4)));
typedef float f32x2 __attribute__((ext_vector_type(2)));
typedef float f32x16 __attribute__((ext_vector_type(16)));
typedef unsigned u32x4 __attribute__((ext_vector_type(4)));
typedef unsigned u32x2 __attribute__((ext_vector_type(2)));
typedef GAS unsigned gu32;

constexpr int DM = 2048, SEQ = 8192, DECB = 8, DECS = 16, PAST = 4096, NS = DECB * DECS, MP = SEQ + NS, MPAD = 8448;
constexpr int PW = 1024, FW = 1024, FH = 8, SH = 16, HD = 128, INAB = 4104, DFF = 5632, NKS = PAST + DECS;
constexpr float EPS = 1e-6f;
constexpr float SCALE = 0.08838834764831845f, RSCALE = 11.313708498984761f, LOG2E = 1.4426950408889634f;
constexpr int NWAVES = 8, NT = 512;
#ifndef PHMASK
#define PHMASK 0xffffffffu
#endif
#define PH(k) ((PHMASK >> (k)) & 1u)
#ifndef DUP
#define DUP -1
#endif
#define REP(k) for (int rep_ = 0; rep_ < ((DUP) == (k) ? 2 : 1); ++rep_)

constexpr size_t O_YP = 0, O_YS = O_YP + (size_t)SEQ * DM, O_POOLP = O_YS + (size_t)NS * DM, O_FKP = O_POOLP + 15 * PW, O_FVP = O_FKP + (size_t)SEQ * FW,
                 O_FLFP = O_FVP + (size_t)SEQ * FW, O_SKP = O_FLFP + (size_t)SEQ * FH, O_SVP = O_SKP + (size_t)SEQ * DM, O_POOLS = O_SVP + (size_t)SEQ * DM,
                 O_FKS = O_POOLS + (size_t)DECB * 15 * PW, O_FVS = O_FKS + (size_t)NS * FW, O_FLFS = O_FVS + (size_t)NS * FW, O_SKS = O_FLFS + (size_t)NS * FH,
                 O_SVS = O_SKS + (size_t)NS * DM, O_END = O_SVS + (size_t)NS * DM;
static_assert(O_END == 68362240, "output size");

constexpr size_t MiB = 1u << 20;
constexpr size_t al1(size_t x) { return (x + MiB - 1) / MiB * MiB; }
constexpr size_t WS_CTL = 0, CTL_ZERO_BYTES = 1 * MiB;
constexpr size_t WS_WIN = 1 * MiB;
constexpr size_t WS_WF = WS_WIN + al1((size_t)4096 * DM * 2);
constexpr size_t WS_WPOOL = WS_WF + al1((size_t)16 * DM * 2);
constexpr size_t WS_WOUT0 = WS_WPOOL + al1((size_t)1024 * 256 * 2);
constexpr size_t WS_WGU0 = WS_WOUT0 + al1((size_t)DM * DM * 2);
constexpr size_t WS_WDN0 = WS_WGU0 + al1((size_t)2 * DFF * DM * 2);
constexpr size_t WS_WQKV = WS_WDN0 + al1((size_t)DM * DFF * 2);
constexpr size_t WS_WOUT1 = WS_WQKV + al1((size_t)3 * DM * DM * 2);
constexpr size_t WS_WGU1 = WS_WOUT1 + al1((size_t)DM * DM * 2);
constexpr size_t WS_WDN1 = WS_WGU1 + al1((size_t)2 * DFF * DM * 2);
constexpr size_t WS_XB = WS_WDN1 + al1((size_t)DM * DFF * 2);
constexpr size_t WS_U = WS_XB + al1((size_t)MPAD * DM * 2);
constexpr size_t WS_QB = WS_U + al1((size_t)MPAD * PW * 4);
constexpr size_t WS_KB = WS_QB + al1((size_t)MPAD * DM * 2);
constexpr size_t WS_VB = WS_KB + al1((size_t)MPAD * DM * 2);
constexpr size_t WS_DB = WS_VB + al1((size_t)MPAD * DM * 2);
constexpr size_t WS_CAT = WS_DB + al1((size_t)MPAD * PW * 2);
constexpr size_t WS_H = WS_CAT + al1((size_t)MPAD * DM * 2);
constexpr size_t WS_HB = WS_H + al1((size_t)MPAD * DM * 4);
constexpr size_t WS_ACT = WS_HB + al1((size_t)MPAD * DM * 2);
constexpr size_t WS_LF = WS_ACT + al1((size_t)MPAD * DFF * 2);
constexpr size_t WS_CUMP = WS_LF + al1((size_t)MPAD * 8 * 4);
constexpr size_t WS_CUMS = WS_CUMP + al1((size_t)SEQ * 8 * 4);
constexpr size_t WS_SCRH = WS_CUMS + al1((size_t)DECB * NKS * 8 * 4);
constexpr size_t WS_SCRHB = WS_SCRH + al1((size_t)MPAD * DM * 4);
constexpr size_t WS_END = WS_SCRHB + al1((size_t)MPAD * DM * 2);

constexpr int CW_TMO = 0, CW_BAR = 4096, CW_KMAX = 8192  , CW_FCNT = 12288  , CW_QHEAD = 14464  , CW_SHEAD = 15360  , CW_SSQ = 16384;
static_assert((CW_SSQ + 6 * MPAD) * 4 <= (int)CTL_ZERO_BYTES, "ctl");

constexpr int RING_BYTES = 131072, LDSCTL_OFF = RING_BYTES, MISC_OFF = LDSCTL_OFF + 320, LDS_BYTES = 147456;

__device__ __forceinline__ unsigned cvt_pk_bf16(float lo, float hi) { unsigned r; asm volatile("v_cvt_pk_bf16_f32 %0, %1, %2" : "=v"(r) : "v"(lo), "v"(hi)); return r; }
__device__ __forceinline__ bf16x8 pack8(f32x4 a, f32x4 b) { u32x4 w = {cvt_pk_bf16(a[0], a[1]), cvt_pk_bf16(a[2], a[3]), cvt_pk_bf16(b[0], b[1]), cvt_pk_bf16(b[2], b[3])}; return __builtin_bit_cast(bf16x8, w); }
__device__ __forceinline__ float wave_sum(float v) {
#pragma unroll
    for (int o = 1; o < 64; o <<= 1) v += __shfl_xor(v, o);
    return v;
}
__device__ __forceinline__ int otid() { int t = threadIdx.x; asm volatile("" : "+v"(t)); return t; }
__device__ __forceinline__ float fexp2(float x) { return __builtin_amdgcn_exp2f(x); }
__device__ __forceinline__ float flog2(float x) { return __builtin_amdgcn_logf(x); }

#define XB_TMO      128
#define XB_XCNT(j)  (256  + 64 * (j))
#define XB_XSUB(j)  (1280 + 64 * (j))
#define XB_XGEN(j)  (2304 + 64 * (j))
#define XB_TOP      3328
#define XB_TOPGEN   3392
#define XCD_BAR_WORDS 3456
#define XB_SPIN_CAP (1u << 22)
__device__ __forceinline__ unsigned xb_ld(unsigned* p)              { return __hip_atomic_load(p, __ATOMIC_RELAXED, __HIP_MEMORY_SCOPE_AGENT); }
__device__ __forceinline__ unsigned xb_add(unsigned* p, unsigned v) { return __hip_atomic_fetch_add(p, v, __ATOMIC_RELAXED, __HIP_MEMORY_SCOPE_AGENT); }
__device__ __forceinline__ unsigned xb_xcc_id() { return (unsigned)__builtin_amdgcn_s_getreg((3 << 11) | 20) & 0xFu; }
#define XB_SPIN(cond, bar) do { unsigned _sp = 0; while (cond) { __builtin_amdgcn_s_sleep(1); \
    if ((++_sp & 255u) == 0u) { if (xb_ld(&(bar)[XB_TMO])) break; if (_sp > XB_SPIN_CAP) { atomicAdd(&(bar)[XB_TMO], 1u); break; } } } } while (0)
struct XcdBarrier { unsigned* bar; unsigned x; volatile LAS unsigned* st; };
__device__ __forceinline__ XcdBarrier xcd_barrier_post(unsigned* bar, volatile LAS unsigned* st) {
    XcdBarrier b; b.bar = bar; b.x = xb_xcc_id(); b.st = st;
    if (threadIdx.x == 0) (void)xb_add(&bar[XB_XCNT(b.x)], 1u);
    return b;
}
__device__ __forceinline__ void xcd_barrier_complete(unsigned* bar, unsigned x, unsigned& nloc, unsigned& nx) {
    const unsigned G = gridDim.x * gridDim.y * gridDim.z;
    unsigned sum, cnt, mine, sp = 0u;
    for (;;) {
        sum = 0u; cnt = 0u; mine = 0u;
#pragma unroll
        for (unsigned j = 0; j < 16; ++j) { const unsigned c = xb_ld(&bar[XB_XCNT(j)]); sum += c; cnt += (c > 0u) ? 1u : 0u; mine = (j == x) ? c : mine; }
        if (sum == G) break;
        __builtin_amdgcn_s_sleep(1);
        if ((++sp & 255u) == 0u) { if (xb_ld(&bar[XB_TMO])) break; if (sp > XB_SPIN_CAP) { atomicAdd(&bar[XB_TMO], 1u); break; } }
    }
    nloc = mine > 0u ? mine : 1u; nx = cnt > 0u ? cnt : 1u;
}
__device__ __forceinline__ void xcd_barrier(const XcdBarrier& b) {
    asm volatile("s_waitcnt vmcnt(0)" ::: "memory");
    __syncthreads();
    if (threadIdx.x == 0) {
        unsigned* bar = b.bar;
        __builtin_amdgcn_s_waitcnt(0);
        unsigned nloc = b.st[0], nx = b.st[1];
        if (nloc == 0u) { xcd_barrier_complete(bar, b.x, nloc, nx); b.st[0] = nloc; b.st[1] = nx; }
        const unsigned old = xb_add(&bar[XB_XSUB(b.x)], 1u);
        const unsigned gen = old / nloc;
        if (old + 1u == (gen + 1u) * nloc) {
            __builtin_amdgcn_fence(__ATOMIC_RELEASE, "agent");
            asm volatile("s_waitcnt vmcnt(0)" ::: "memory");
            const unsigned og = xb_add(&bar[XB_TOP], 1u);
            const unsigned tg = og / nx;
            if (og + 1u == (tg + 1u) * nx) xb_add(&bar[XB_TOPGEN], 1u);
            else XB_SPIN(xb_ld(&bar[XB_TOPGEN]) == tg, bar);
            __builtin_amdgcn_fence(__ATOMIC_ACQUIRE, "agent");
            xb_add(&bar[XB_XGEN(b.x)], 1u);
            asm volatile("s_waitcnt vmcnt(0)" ::: "memory");
        } else {
            XB_SPIN(xb_ld(&bar[XB_XGEN(b.x)]) == gen, bar);
            __builtin_amdgcn_fence(__ATOMIC_ACQUIRE, "agent");
            asm volatile("s_waitcnt vmcnt(0)" ::: "memory");
        }
    }
    __syncthreads();
}

namespace pg8 {
constexpr int BM = 256, BK = 64, HALF = 128, HTB = HALF * BK * 2, NXCD = 8, WGM = 8;
__host__ __device__ __forceinline__ int lds_byte(int r, int c) { const int st = (r >> 4) * 2 + (c >> 5), rr = r & 15, cc = c & 31, ob = rr * 64 + cc * 2; return st * 1024 + (ob ^ (((ob >> 9) & 1) << 5)); }
__host__ __device__ __forceinline__ void stage_rc(int b, int& R, int& C) { const int st = b / 1024, sb = b % 1024, swz = sb ^ (((sb >> 9) & 1) << 5); R = (st >> 1) * 16 + swz / 64; C = (st & 1) * 32 + (swz % 64) / 2; }
__host__ __device__ __forceinline__ int perm32(int rho) { const int n = rho >> 4, i = rho & 15; return 8 * (i >> 2) + 4 * n + (i & 3); }
struct Unit { int pm, pn; };
struct Gemm { const bf16* A; const bf16* Bt; int lda, ldb, K, a_koff; };
struct StaticOrder {
    int nM, nN, nwg, G, c;
    __device__ void init(int nM_, int nN_, int G_, int c_) { nM = nM_; nN = nN_; nwg = nM * nN; G = G_; c = c_; }
    __device__ bool next(int i, Unit& u) const {
        const long L = (long)i * G + c; if (L >= nwg) return false;
        int wgid = (int)L; { const int q = nwg / NXCD, r = nwg % NXCD, xcd = wgid % NXCD, off = wgid / NXCD; wgid = (xcd < r ? xcd * (q + 1) : r * (q + 1) + (xcd - r) * q) + off; }
        const int nig = WGM * nN, gid = wgid / nig, fm = gid * WGM, gsz = (nM - fm) < WGM ? (nM - fm) : WGM;
        u.pm = fm + ((wgid % nig) % gsz); u.pn = (wgid % nig) / gsz; return true;
    }
};
struct BalancedOrder {
    int R, c, G;
    __device__ bool next(int i, Unit& u) const {
        if (G == 256) { if (i >= R) return false; const int xcd = c & 7, r = c >> 3; u.pm = (xcd >> 1) * 8 + (r & 7); u.pn = (2 * i + (xcd & 1)) * 4 + (r >> 3); return true; }
        const int L = i * G + c; if (L >= 32 * 8 * R) return false; u.pm = L & 31; u.pn = L >> 5; return true;
    }
};
template <class Epi, class Sched, bool ALIGN_EPI>
__device__ __forceinline__ void gemm_phase(LAS unsigned char* lds, const Gemm g, const Sched& S, const Epi& E) {
    const int tid = otid(), wid = __builtin_amdgcn_readfirstlane(tid >> 6), lane = tid & 63, wr = wid >> 2, wc = wid & 3, fr = lane & 15, fq = lane >> 4;
    const int K = g.K, nt = K / BK;
    unsigned voffA[2], voffB[2];
#pragma unroll
    for (int i = 0; i < 2; ++i) { int R, C; stage_rc(tid * 16 + i * 8192, R, C); const int Rb = (R & ~31) + perm32(R & 31);
        voffA[i] = (unsigned)(R * g.lda + C) * 2u; voffB[i] = (unsigned)(Rb * g.ldb + C) * 2u; }
    const size_t kstep = (size_t)(BK * 2);
    const size_t hstepA = (size_t)HALF * g.lda * 2, hstepB = (size_t)HALF * g.ldb * 2;
    const size_t tstepA = 2 * hstepA, tstepB = 2 * hstepB;
    const unsigned ldsw = (unsigned)wid * 1024u;
    const int aoff = lds_byte(wr * 64 + fr, fq * 8), boff = lds_byte(wc * 32 + fr, fq * 8);
#define PG8_SA(b, h) (((b) * 2 + (h)) * HTB)
#define PG8_SB(b, h) ((4 + (b) * 2 + (h)) * HTB)
    const unsigned ldsb0 = (unsigned)(uintptr_t)lds + ldsw;
#define PG8_STAGE(bufoff, gbase, voff) do { _Pragma("unroll") for (int _i = 0; _i < 2; ++_i) { unsigned keep_; \
        asm volatile("s_mov_b32 %0, m0\n\ts_mov_b32 m0, %3\n\ts_nop 0\n\tglobal_load_lds_dwordx4 %1, %2\n\ts_mov_b32 m0, %0" \
            : "=&s"(keep_) : "v"((voff)[_i]), "s"((const void*)(gbase)), "s"(ldsb0 + (unsigned)(bufoff) + (unsigned)(_i * 8192)) : "memory"); } } while (0)
#define PG8_LDA(dst, b, h) do { _Pragma("unroll") for (int m = 0; m < 4; ++m) _Pragma("unroll") for (int k = 0; k < 2; ++k) dst[m][k] = *(const LAS bf16x8*)(lds + PG8_SA(b, h) + aoff + m * 2048 + k * 1024); } while (0)
#define PG8_LDB(dst, b, h) do { _Pragma("unroll") for (int n = 0; n < 2; ++n) _Pragma("unroll") for (int k = 0; k < 2; ++k) dst[n][k] = *(const LAS bf16x8*)(lds + PG8_SB(b, h) + boff + n * 2048 + k * 1024); } while (0)
#define PG8_MMA(ai, bj, At, Bt) do { __builtin_amdgcn_s_setprio(1); _Pragma("unroll") for (int m = 0; m < 4; ++m) _Pragma("unroll") for (int n = 0; n < 2; ++n) _Pragma("unroll") for (int k = 0; k < 2; ++k) \
        acc[ai][bj][m][n] = __builtin_amdgcn_mfma_f32_16x16x32_bf16(Bt[n][k], At[m][k], acc[ai][bj][m][n], 0, 0, 0); __builtin_amdgcn_s_setprio(0); } while (0)
#define PG8_WAIT_V(n) asm volatile("s_waitcnt vmcnt(" #n ")" ::: "memory")
#define PG8_WAIT_L(n) asm volatile("s_waitcnt lgkmcnt(" #n ")" ::: "memory")
#define PG8_BAR __builtin_amdgcn_s_barrier()
#define PG8_SCHED __builtin_amdgcn_sched_barrier(0)
    Unit cur, nxt; int ui = 0;
    if (!S.next(0, cur)) return;
    f32x4 acc[2][2][4][2];
#pragma unroll
    for (int a = 0; a < 2; ++a)
#pragma unroll
        for (int b = 0; b < 2; ++b)
#pragma unroll
            for (int m = 0; m < 4; ++m)
#pragma unroll
                for (int n = 0; n < 2; ++n) acc[a][b][m][n] = (f32x4){0.f, 0.f, 0.f, 0.f};
    bf16x8 At[4][2], B0[2][2], B1[2][2];
    float pre[Epi::NPRE > 0 ? Epi::NPRE : 1];
    if constexpr (Epi::NPRE > 0) E.preload(cur, wr, fr, pre);
    const char* cA = (const char*)g.A + (size_t)cur.pm * tstepA + (size_t)cur.pn * g.a_koff * 2; const char* cB = (const char*)g.Bt + (size_t)cur.pn * tstepB;
    PG8_STAGE(PG8_SB(0, 0), cB, voffB); PG8_STAGE(PG8_SB(0, 1), cB + hstepB, voffB); PG8_STAGE(PG8_SA(0, 0), cA, voffA); PG8_STAGE(PG8_SA(0, 1), cA + hstepA, voffA);
    if (wr == 1) PG8_BAR;
    PG8_WAIT_V(2); PG8_BAR;
    PG8_STAGE(PG8_SB(1, 0), cB + kstep, voffB); PG8_STAGE(PG8_SA(1, 0), cA + kstep, voffA); PG8_STAGE(PG8_SB(1, 1), cB + hstepB + kstep, voffB);
    PG8_WAIT_V(6); PG8_BAR;
    for (;;) {
        const bool has_next = S.next(ui + 1, nxt);
        const char* nA = has_next ? (const char*)g.A + (size_t)nxt.pm * tstepA + (size_t)nxt.pn * g.a_koff * 2 : cA; const char* nB = has_next ? (const char*)g.Bt + (size_t)nxt.pn * tstepB : cB;
#pragma unroll 1
        for (int t = 0; t < nt; t += 2) {
            const bool last = (t == nt - 2);
            const char* a1 = cA + (size_t)(t + 1) * kstep;
            const char* a2 = last ? nA : cA + (size_t)(t + 2) * kstep; const char* b2 = last ? nB : cB + (size_t)(t + 2) * kstep;
            const char* a3 = a2 + kstep; const char* b3 = b2 + kstep;
            PG8_LDB(B0, 0, 0); PG8_LDB(B1, 0, 1); PG8_SCHED; PG8_LDA(At, 0, 0); PG8_STAGE(PG8_SA(1, 1), a1 + hstepA, voffA);
            PG8_WAIT_V(8); PG8_WAIT_L(0); PG8_BAR; PG8_MMA(0, 0, At, B0); PG8_MMA(0, 1, At, B1); PG8_BAR; PG8_SCHED;
            PG8_LDA(At, 0, 1); PG8_STAGE(PG8_SB(0, 0), b2, voffB); PG8_STAGE(PG8_SB(0, 1), b2 + hstepB, voffB); PG8_STAGE(PG8_SA(0, 0), a2, voffA);
            PG8_WAIT_V(8); PG8_WAIT_L(0); PG8_BAR; PG8_MMA(1, 0, At, B0); PG8_MMA(1, 1, At, B1); PG8_BAR; PG8_SCHED;
            PG8_LDB(B0, 1, 0); PG8_LDB(B1, 1, 1); PG8_SCHED; PG8_LDA(At, 1, 0); PG8_STAGE(PG8_SA(0, 1), a2 + hstepA, voffA);
            PG8_WAIT_V(8); PG8_WAIT_L(0); PG8_BAR; PG8_MMA(0, 0, At, B0); PG8_MMA(0, 1, At, B1); PG8_BAR; PG8_SCHED;
            PG8_LDA(At, 1, 1); PG8_STAGE(PG8_SB(1, 0), b3, voffB); PG8_STAGE(PG8_SB(1, 1), b3 + hstepB, voffB); PG8_STAGE(PG8_SA(1, 0), a3, voffA);
            PG8_WAIT_V(8); PG8_WAIT_L(0); PG8_BAR; PG8_MMA(1, 0, At, B0); PG8_MMA(1, 1, At, B1); PG8_BAR; PG8_SCHED;
        }
        if constexpr (ALIGN_EPI) { if (wr == 0) PG8_BAR; }
        if constexpr (Epi::NPRE > 0) E(acc, cur, wr, wc, fr, fq, pre); else
        if constexpr (!Epi::AFTER_DRAIN) E(acc, cur, wr, wc, fr, fq);
        if (!has_next) break;
#pragma unroll
        for (int a = 0; a < 2; ++a)
#pragma unroll
            for (int b = 0; b < 2; ++b)
#pragma unroll
                for (int m = 0; m < 4; ++m)
#pragma unroll
                    for (int n = 0; n < 2; ++n) acc[a][b][m][n] = (f32x4){0.f, 0.f, 0.f, 0.f};
        cur = nxt; cA = nA; cB = nB; ++ui;
        if constexpr (Epi::NPRE > 0) E.preload(cur, wr, fr, pre);
        if constexpr (ALIGN_EPI) { if (wr == 1) PG8_BAR; }
    }
    PG8_WAIT_V(0);
    if constexpr (!ALIGN_EPI) { if (wr == 0) PG8_BAR; }
    PG8_BAR;
    if constexpr (Epi::AFTER_DRAIN) E.after(acc, cur, wr, wc, fr, fq);
#undef PG8_SA
#undef PG8_SB
#undef PG8_STAGE
#undef PG8_LDA
#undef PG8_LDB
#undef PG8_MMA
#undef PG8_WAIT_V
#undef PG8_WAIT_L
#undef PG8_BAR
#undef PG8_SCHED
}
}

typedef f32x4 Acc[2][2][4][2];
__device__ __forceinline__ float rs_of(const float* ssq, int row) { return __builtin_amdgcn_rsqf(ssq[row] * (1.f / DM) + EPS); }
__device__ __forceinline__ float rs_val(float ssqv) { return __builtin_amdgcn_rsqf(ssqv * (1.f / DM) + EPS); }
__device__ __forceinline__ void st_bf16x8(bf16* p, f32x4 a, f32x4 b) { *(bf16x8*)p = pack8(a, b); }

struct EpiIn {
    static constexpr int NPRE = 8;
    static constexpr bool AFTER_DRAIN = false;
    const float* ssq; bf16* UB; float* poolp; bf16* QB; bf16* KB; bf16* VB; float* fk; float* fv;
    __device__ __forceinline__ void preload(const pg8::Unit& u, int wr, int fr, float* rsv) const {
#pragma unroll
        for (int k = 0; k < 8; ++k) rsv[k] = ssq[u.pm * 256 + (k >> 2) * 128 + wr * 64 + (k & 3) * 16 + fr]; }
    __device__ __forceinline__ void operator()(const Acc& acc, const pg8::Unit& u, int wr, int wc, int fr, int fq, const float* rsv) const {
        const int sec = u.pn >> 2, cin = (u.pn & 3) * 256 + wc * 32 + fq * 8;
#pragma unroll
        for (int ai = 0; ai < 2; ++ai)
#pragma unroll
            for (int m = 0; m < 4; ++m) { const int row = u.pm * 256 + ai * 128 + wr * 64 + m * 16 + fr; const float rs = rs_val(rsv[ai * 4 + m]);
#pragma unroll
                for (int bj = 0; bj < 2; ++bj) { const f32x4 v0 = acc[ai][bj][m][0] * rs, v1 = acc[ai][bj][m][1] * rs; const int c = cin + bj * 128;
                    if (sec == 0) { st_bf16x8(UB + (size_t)row * PW + c, v0, v1);
                        if (row >= SEQ - 15) { float* p = poolp + (size_t)(row - (SEQ - 15)) * PW + c; *(f32x4*)p = v0; *(f32x4*)(p + 4) = v1; } }
                    else if (sec == 1) st_bf16x8(QB + (size_t)row * DM + c, v0, v1);
                    else if (sec == 2) { float* p = fk + (size_t)row * FW + c; *(f32x4*)p = v0; *(f32x4*)(p + 4) = v1; st_bf16x8(KB + (size_t)row * DM + c, v0, v1); }
                    else { float* p = fv + (size_t)row * FW + c; *(f32x4*)p = v0; *(f32x4*)(p + 4) = v1; st_bf16x8(VB + (size_t)row * DM + c, v0, v1); } } }
    }
};
__device__ __forceinline__ void wg_max8(LAS float* km, float s, int lane, int wave, int tid, unsigned* dst) {
    __syncthreads();
    if ((lane & 0x31) == 0) km[wave * 8 + ((lane >> 1) & 7)] = s;
    __syncthreads();
    if (tid < 8) { float m = km[tid];
#pragma unroll
        for (int w2 = 1; w2 < 8; ++w2) m = fmaxf(m, km[w2 * 8 + tid]);
        atomicMax(dst + tid, __float_as_uint(m)); }
}
struct EpiQkv {
    static constexpr int NPRE = 8;
    static constexpr bool AFTER_DRAIN = false;
    const float* ssq; bf16* QB; bf16* KB; bf16* VB; float* sk; float* sv;
    __device__ __forceinline__ void preload(const pg8::Unit& u, int wr, int fr, float* rsv) const {
#pragma unroll
        for (int k = 0; k < 8; ++k) rsv[k] = ssq[u.pm * 256 + (k >> 2) * 128 + wr * 64 + (k & 3) * 16 + fr]; }
    __device__ __forceinline__ void operator()(const Acc& acc, const pg8::Unit& u, int wr, int wc, int fr, int fq, const float* rsv) const {
        const int sec = u.pn >> 3, cin = (u.pn & 7) * 256 + wc * 32 + fq * 8;
#pragma unroll
        for (int ai = 0; ai < 2; ++ai)
#pragma unroll
            for (int m = 0; m < 4; ++m) { const int row = u.pm * 256 + ai * 128 + wr * 64 + m * 16 + fr; const float rs = rs_val(rsv[ai * 4 + m]);
#pragma unroll
                for (int bj = 0; bj < 2; ++bj) { const f32x4 v0 = acc[ai][bj][m][0] * rs, v1 = acc[ai][bj][m][1] * rs; const int c = cin + bj * 128;
                    if (sec == 0) st_bf16x8(QB + (size_t)row * DM + c, v0, v1);
                    else if (sec == 1) { float* p = sk + (size_t)row * DM + c; *(f32x4*)p = v0; *(f32x4*)(p + 4) = v1; st_bf16x8(KB + (size_t)row * DM + c, v0, v1); }
                    else { if (ai == 1) { float* p = sv + (size_t)row * DM + c; *(f32x4*)p = v0; *(f32x4*)(p + 4) = v1; }
                        st_bf16x8(VB + (size_t)row * DM + c, v0, v1); } } }
    }
};
struct EpiPool {
    static constexpr int NPRE = 0;
    static constexpr bool AFTER_DRAIN = false;
    const float* pscale; bf16* CAT;
    __device__ __forceinline__ void operator()(const Acc& acc, const pg8::Unit& u, int wr, int wc, int fr, int fq) const {
        f32x4 sc[2][2];
#pragma unroll
        for (int bj = 0; bj < 2; ++bj) { const int c = u.pn * 256 + bj * 128 + wc * 32 + fq * 8; sc[bj][0] = *(const f32x4*)(pscale + c); sc[bj][1] = *(const f32x4*)(pscale + c + 4); }
        __builtin_amdgcn_sched_barrier(0);
#pragma unroll
        for (int bj = 0; bj < 2; ++bj) { const int c = u.pn * 256 + bj * 128 + wc * 32 + fq * 8;
#pragma unroll
            for (int ai = 0; ai < 2; ++ai)
#pragma unroll
                for (int m = 0; m < 4; ++m) { const int row = u.pm * 256 + ai * 128 + wr * 64 + m * 16 + fr;
                    st_bf16x8(CAT + (size_t)row * DM + c, acc[ai][bj][m][0] * sc[bj][0], acc[ai][bj][m][1] * sc[bj][1]); } }
    }
};
__device__ __forceinline__ float bf2f(short b) { return __uint_as_float(((unsigned)(unsigned short)b) << 16); }
constexpr bool RES_LO = false;
__device__ __forceinline__ void ld_hilo(const bf16* hi, const bf16* lo, f32x4& a, f32x4& b) { const bf16x8 h = *(const bf16x8*)hi;
    if (RES_LO) { const bf16x8 l = *(const bf16x8*)lo;
#pragma unroll
        for (int e = 0; e < 4; ++e) { a[e] = bf2f(h[e]) + bf2f(l[e]); b[e] = bf2f(h[4 + e]) + bf2f(l[4 + e]); } }
    else {
#pragma unroll
        for (int e = 0; e < 4; ++e) { a[e] = bf2f(h[e]); b[e] = bf2f(h[4 + e]); } } }
__device__ __forceinline__ void st_hilo(bf16* hi, bf16* lo, f32x4 a, f32x4 b) { const bf16x8 h = pack8(a, b); *(bf16x8*)hi = h;
    if (RES_LO) { f32x4 ra, rb;
#pragma unroll
        for (int e = 0; e < 4; ++e) { ra[e] = a[e] - bf2f(h[e]); rb[e] = b[e] - bf2f(h[4 + e]); }
        *(bf16x8*)lo = pack8(ra, rb); } }
template <bool RESF32> struct EpiRes {
    static constexpr int NPRE = 0;
    static constexpr bool AFTER_DRAIN = false;
    const float* resf; bf16* HB; bf16* HL; float* ssq;
    __device__ __forceinline__ void operator()(const Acc& acc, const pg8::Unit& u, int wr, int wc, int fr, int fq) const {
        float sq[8];
#pragma unroll
        for (int ai = 0; ai < 2; ++ai) {
            f32x4 rf[RESF32 ? 4 : 1][2][2]; bf16x8 rb[RESF32 ? 1 : 4][2];
#pragma unroll
            for (int m = 0; m < 4; ++m)
#pragma unroll
                for (int bj = 0; bj < 2; ++bj) { const size_t o = (size_t)(u.pm * 256 + ai * 128 + wr * 64 + m * 16 + fr) * DM + u.pn * 256 + bj * 128 + wc * 32 + fq * 8;
                    if (RESF32) { rf[m][bj][0] = *(const f32x4*)(resf + o); rf[m][bj][1] = *(const f32x4*)(resf + o + 4); } else rb[m][bj] = *(const bf16x8*)(HB + o); }
            __builtin_amdgcn_sched_barrier(0);
#pragma unroll
            for (int m = 0; m < 4; ++m) { const int row = u.pm * 256 + ai * 128 + wr * 64 + m * 16 + fr; float s = 0.f;
#pragma unroll
                for (int bj = 0; bj < 2; ++bj) { const int c = u.pn * 256 + bj * 128 + wc * 32 + fq * 8; const size_t o = (size_t)row * DM + c;
                    f32x4 r0, r1;
                    if (RESF32) { r0 = rf[m][bj][0]; r1 = rf[m][bj][1]; }
                    else {
#pragma unroll
                        for (int e = 0; e < 4; ++e) { r0[e] = bf2f(rb[m][bj][e]); r1[e] = bf2f(rb[m][bj][4 + e]); } }
                    const f32x4 v0 = acc[ai][bj][m][0] + r0, v1 = acc[ai][bj][m][1] + r1;
                    st_hilo(HB + o, HL + o, v0, v1);
                    s += (v0[0] * v0[0] + v0[1] * v0[1]) + (v0[2] * v0[2] + v0[3] * v0[3]) + (v1[0] * v1[0] + v1[1] * v1[1]) + (v1[2] * v1[2] + v1[3] * v1[3]); }
                s += __shfl_xor(s, 16); s += __shfl_xor(s, 32); sq[ai * 4 + m] = s; }
        }
        if (fq == 0) {
#pragma unroll
            for (int k = 0; k < 8; ++k) atomicAdd(ssq + u.pm * 256 + (k >> 2) * 128 + wr * 64 + (k & 3) * 16 + fr, sq[k]); }
    }
};
__device__ __forceinline__ void wait_count(unsigned* cnt, unsigned need, unsigned* tmo) {
    __hip_atomic_fetch_add(cnt, 1u, __ATOMIC_RELAXED, __HIP_MEMORY_SCOPE_AGENT);
    unsigned sp = 0;
    while (__hip_atomic_load(cnt, __ATOMIC_RELAXED, __HIP_MEMORY_SCOPE_AGENT) < need) { __builtin_amdgcn_s_sleep(2);
        if ((++sp & 255u) == 0u) { if (__hip_atomic_load(tmo, __ATOMIC_RELAXED, __HIP_MEMORY_SCOPE_AGENT)) break; if (sp > (1u << 22)) { atomicAdd(tmo, 1u); break; } } }
}
struct EpiResFinal {
    static constexpr int NPRE = 0;
    static constexpr bool AFTER_DRAIN = true;
    const bf16* HB; const bf16* HL; float* Y; const float* lnf; float* ssq; unsigned* cnt; unsigned* tmo;
    __device__ __forceinline__ void operator()(const Acc&, const pg8::Unit&, int, int, int, int) const {}
    __device__ __forceinline__ void after(Acc& acc, const pg8::Unit& u, int wr, int wc, int fr, int fq) const {
        {
            bf16x8 rb[2][4][2];
#pragma unroll
            for (int ai = 0; ai < 2; ++ai)
#pragma unroll
                for (int m = 0; m < 4; ++m)
#pragma unroll
                    for (int bj = 0; bj < 2; ++bj) rb[ai][m][bj] = *(const bf16x8*)(HB + (size_t)(u.pm * 256 + ai * 128 + wr * 64 + m * 16 + fr) * DM + u.pn * 256 + bj * 128 + wc * 32 + fq * 8);
            __builtin_amdgcn_sched_barrier(0);
#pragma unroll
            for (int ai = 0; ai < 2; ++ai)
#pragma unroll
                for (int m = 0; m < 4; ++m) { const int row = u.pm * 256 + ai * 128 + wr * 64 + m * 16 + fr; float s = 0.f;
#pragma unroll
                    for (int bj = 0; bj < 2; ++bj) { f32x4 r0, r1;
#pragma unroll
                        for (int e = 0; e < 4; ++e) { r0[e] = bf2f(rb[ai][m][bj][e]); r1[e] = bf2f(rb[ai][m][bj][4 + e]); }
                        const f32x4 v0 = acc[ai][bj][m][0] + r0, v1 = acc[ai][bj][m][1] + r1;
                        acc[ai][bj][m][0] = v0; acc[ai][bj][m][1] = v1;
                        s += (v0[0] * v0[0] + v0[1] * v0[1]) + (v0[2] * v0[2] + v0[3] * v0[3]) + (v1[0] * v1[0] + v1[1] * v1[1]) + (v1[2] * v1[2] + v1[3] * v1[3]); }
                    s += __shfl_xor(s, 16); s += __shfl_xor(s, 32);
                    if (fq == 0) atomicAdd(ssq + row, s); }
        }
        asm volatile("s_waitcnt vmcnt(0)" ::: "memory");
        __syncthreads();
        if (threadIdx.x == 0) wait_count(cnt + 64 * u.pm, 8u, tmo);
        __syncthreads();
        float rsv[8]; f32x4 ln[2][2];
#pragma unroll
        for (int k = 0; k < 8; ++k) rsv[k] = __hip_atomic_load(ssq + u.pm * 256 + (k >> 2) * 128 + wr * 64 + (k & 3) * 16 + fr, __ATOMIC_RELAXED, __HIP_MEMORY_SCOPE_AGENT);
#pragma unroll
        for (int bj = 0; bj < 2; ++bj) { const int c = u.pn * 256 + bj * 128 + wc * 32 + fq * 8; ln[bj][0] = *(const f32x4*)(lnf + c); ln[bj][1] = *(const f32x4*)(lnf + c + 4); }
        __builtin_amdgcn_sched_barrier(0);
#pragma unroll
        for (int ai = 0; ai < 2; ++ai)
#pragma unroll
            for (int m = 0; m < 4; ++m) { const int row = u.pm * 256 + ai * 128 + wr * 64 + m * 16 + fr;
                const float rs = rs_val(rsv[ai * 4 + m]);
#pragma unroll
                for (int bj = 0; bj < 2; ++bj) { const int c = u.pn * 256 + bj * 128 + wc * 32 + fq * 8; float* yp = Y + (size_t)row * DM + c;
                    *(f32x4*)yp = acc[ai][bj][m][0] * rs * ln[bj][0]; *(f32x4*)(yp + 4) = acc[ai][bj][m][1] * rs * ln[bj][1]; } }
    }
};
__device__ __forceinline__ float swiglu1(float g, float u) { return g * u * __builtin_amdgcn_rcpf(1.f + fexp2(-g * LOG2E)); }
struct EpiGU {
    static constexpr int NPRE = 8;
    static constexpr bool AFTER_DRAIN = false;
    const float* ssq; bf16* ACT;
    __device__ __forceinline__ void preload(const pg8::Unit& u, int wr, int fr, float* rsv) const {
#pragma unroll
        for (int k = 0; k < 8; ++k) rsv[k] = ssq[u.pm * 256 + (k >> 2) * 128 + wr * 64 + (k & 3) * 16 + fr]; }
    __device__ __forceinline__ void operator()(const Acc& acc, const pg8::Unit& u, int wr, int wc, int fr, int fq, const float* rsv) const {
        const int c = u.pn * 128 + wc * 32 + fq * 8;
#pragma unroll
        for (int ai = 0; ai < 2; ++ai)
#pragma unroll
            for (int m = 0; m < 4; ++m) { const int row = u.pm * 256 + ai * 128 + wr * 64 + m * 16 + fr; const float rs = rs_val(rsv[ai * 4 + m]);
                f32x4 o0, o1;
#pragma unroll
                for (int e = 0; e < 4; ++e) { o0[e] = swiglu1(acc[ai][0][m][0][e] * rs, acc[ai][1][m][0][e] * rs); o1[e] = swiglu1(acc[ai][0][m][1][e] * rs, acc[ai][1][m][1][e] * rs); }
                st_bf16x8(ACT + (size_t)row * DFF + c, o0, o1); __builtin_amdgcn_sched_barrier(0); }
    }
};

template <int NB, int MT, class Map, class Epi>
__device__ __forceinline__ void small_gemm_t(LAS unsigned char* lds, int nunits, int lda, int ldb, int K, const Map& M_, const Epi& E, int G, int c) {
    static_assert(MT == 8 || (MT == 4 && NB == 1), "small_gemm geometry");
    const int tid = otid(), wid = __builtin_amdgcn_readfirstlane(tid >> 6), lane = tid & 63, fr = lane & 15, fq = lane >> 4;
    const int kw = K / 8, nks = kw / 32;
    LAS f32x4* red = (LAS f32x4*)lds;
    for (int t = c; t < nunits; t += G) {
        const int ct = MT == 8 ? t : (t >> 1), r0 = MT == 8 ? 0 : (t & 1) * 64;
        const bf16 *a, *b0, *b1; M_.get(ct, a, b0, b1); a += (size_t)r0 * lda;
        f32x4 acc[NB][MT];
#pragma unroll
        for (int j = 0; j < NB; ++j)
#pragma unroll
            for (int m = 0; m < MT; ++m) acc[j][m] = (f32x4){0.f, 0.f, 0.f, 0.f};
        const bf16* ap = a + (size_t)fr * lda + wid * kw + fq * 8;
        const bf16* bp0 = b0 + (size_t)fr * ldb + wid * kw + fq * 8;
        const bf16* bp1 = b1 + (size_t)fr * ldb + wid * kw + fq * 8;
        constexpr int UB = (NB == 1 ? 4 : 2) * (8 / MT);
#pragma unroll 1
        for (int ks = 0; ks < nks; ks += UB) {
            bf16x8 af[UB][MT], bf0[UB], bf1[UB];
#pragma unroll
            for (int u = 0; u < UB; ++u) if (ks + u < nks) {
#pragma unroll
                for (int m = 0; m < MT; ++m) af[u][m] = *(const bf16x8*)(ap + (size_t)m * 16 * lda + (ks + u) * 32);
                bf0[u] = *(const bf16x8*)(bp0 + (ks + u) * 32);
                if (NB == 2) bf1[u] = *(const bf16x8*)(bp1 + (ks + u) * 32); }
            __builtin_amdgcn_sched_barrier(0);
#pragma unroll
            for (int u = 0; u < UB; ++u) if (ks + u < nks) {
#pragma unroll
                for (int m = 0; m < MT; ++m) { acc[0][m] = __builtin_amdgcn_mfma_f32_16x16x32_bf16(bf0[u], af[u][m], acc[0][m], 0, 0, 0);
                    if (NB == 2) acc[NB - 1][m] = __builtin_amdgcn_mfma_f32_16x16x32_bf16(bf1[u], af[u][m], acc[NB - 1][m], 0, 0, 0); } }
            __builtin_amdgcn_sched_barrier(0);
        }
#pragma unroll
        for (int j = 0; j < NB; ++j)
#pragma unroll
            for (int m = 0; m < MT; ++m) red[(j * 64 + wid * 8 + m) * 64 + lane] = acc[j][m];
        __syncthreads();
        const bool act = MT == 8 || wid < MT;
        f32x4 v[NB];
        if (act) {
#pragma unroll
            for (int j = 0; j < NB; ++j) { v[j] = red[(j * 64 + wid) * 64 + lane];
#pragma unroll
                for (int s = 1; s < 8; ++s) v[j] += red[(j * 64 + s * 8 + wid) * 64 + lane]; }
        }
        if constexpr (Epi::TWO_STAGE) {
            f32x4 h = {0.f, 0.f, 0.f, 0.f};
            if (act) h = E.stage1(ct, r0 + wid * 16 + fr, fq * 4, v[0]);
            E.wait_all();
            if (act) E.stage2(ct, r0 + wid * 16 + fr, fq * 4, h);
        } else if (act) E(ct, r0 + wid * 16 + fr, fq * 4, v[0], v[NB - 1]);
        __syncthreads();
    }
}
template <int NB, class Map, class Epi>
__device__ __forceinline__ void small_gemm(LAS unsigned char* lds, int nunits, int lda, int ldb, int K, const Map& M_, const Epi& E, int G, int c) { small_gemm_t<NB, 8>(lds, nunits, lda, ldb, K, M_, E, G, c); }

namespace att {
constexpr int KVB = 64, SHM = KVB * HD * 2;
constexpr int L_V = 0, L_K = 4 * SHM, L_BIAS = LDSCTL_OFF + 1024, L_WS = L_BIAS + 4 * 256, L_FLAG = L_WS + NWAVES * 64 * 4, L_END = L_FLAG + 64;
static_assert(8 * SHM <= RING_BYTES && L_END <= LDS_BYTES, "attention LDS");
#define KSWZ(row, colB) ((row) * 256 + ((colB) ^ (((row) & 7) << 4)))
#define SBAR() __builtin_amdgcn_sched_barrier(0)
__device__ __forceinline__ int v_st(int k, int c) { const int kk = (k & ~0xC) | ((k & 4) << 1) | ((k & 8) >> 1); return ((kk >> 3) * 4 + (c >> 5)) * 512 + ((kk & 7) * 32 + (c & 31)) * 2; }
__device__ __forceinline__ int v_rd_base(int lane) { return ((lane & 3) << 3) | (((lane >> 2) & 3) << 6) | (((lane >> 4) & 1) << 5) | (((lane >> 5) & 1) << 8); }
constexpr int v_rd_off(int d0, int ks, int half) { return d0 * 512 + ks * 4096 + half * 2048; }
__device__ __forceinline__ int crow(int r, int hi) { return (r & 3) + 8 * (r >> 2) + 4 * hi; }

__device__ __forceinline__ void qkt(f32x16& p0, f32x16& p1, LAS const char* Kb, int r32, int hi, const bf16x8* qr) {
    LAS const char* kb[4];
#pragma unroll
    for (int dd = 0; dd < 4; ++dd) kb[dd] = Kb + KSWZ(r32, (dd * 16 + hi * 8) * 2);
#pragma unroll
    for (int d0 = 0; d0 < 8; ++d0) { LAS const char* a = kb[d0 & 3] + (d0 >> 2) * 128;
        const bf16x8 b0 = *(LAS const bf16x8*)a, b1 = *(LAS const bf16x8*)(a + 32 * 256);
        p0 = __builtin_amdgcn_mfma_f32_32x32x16_bf16(b0, qr[d0], p0, 0, 0, 0);
        p1 = __builtin_amdgcn_mfma_f32_32x32x16_bf16(b1, qr[d0], p1, 0, 0, 0); }
}
__device__ __forceinline__ void pv_tile(f32x16* o, unsigned vb0, bf16x8 pa0, bf16x8 pa1, bf16x8 pa2, bf16x8 pa3) {
#define TRRD(dst, off) asm volatile("ds_read_b64_tr_b16 %0, %1 offset:%2" : "=&v"(dst) : "v"(vb0), "i"(off) : "memory")
#define PV_D0(d0) do { s16x4 l0, l1, l2, l3, h0, h1, h2, h3; constexpr int b_ = v_rd_off(d0, 0, 0); \
        TRRD(l0, b_); TRRD(h0, b_ + 2048); TRRD(l1, b_ + 4096); TRRD(h1, b_ + 6144); TRRD(l2, b_ + 8192); TRRD(h2, b_ + 10240); TRRD(l3, b_ + 12288); TRRD(h3, b_ + 14336); \
        asm volatile("s_waitcnt lgkmcnt(0)" ::: "memory"); SBAR(); \
        o[d0] = __builtin_amdgcn_mfma_f32_32x32x16_bf16(pa0, (bf16x8){l0[0], l0[1], l0[2], l0[3], h0[0], h0[1], h0[2], h0[3]}, o[d0], 0, 0, 0); \
        o[d0] = __builtin_amdgcn_mfma_f32_32x32x16_bf16(pa1, (bf16x8){l1[0], l1[1], l1[2], l1[3], h1[0], h1[1], h1[2], h1[3]}, o[d0], 0, 0, 0); \
        o[d0] = __builtin_amdgcn_mfma_f32_32x32x16_bf16(pa2, (bf16x8){l2[0], l2[1], l2[2], l2[3], h2[0], h2[1], h2[2], h2[3]}, o[d0], 0, 0, 0); \
        o[d0] = __builtin_amdgcn_mfma_f32_32x32x16_bf16(pa3, (bf16x8){l3[0], l3[1], l3[2], l3[3], h3[0], h3[1], h3[2], h3[3]}, o[d0], 0, 0, 0); } while (0)
    PV_D0(0); PV_D0(1); PV_D0(2); PV_D0(3);
#undef PV_D0
#undef TRRD
}
__device__ __forceinline__ void pack_p(const f32x16& p0, const f32x16& p1, bf16x8& pa0, bf16x8& pa1, bf16x8& pa2, bf16x8& pa3) {
#define PK4(P, B_, OUT) do { unsigned a0 = cvt_pk_bf16(P[B_+0], P[B_+1]), a1 = cvt_pk_bf16(P[B_+2], P[B_+3]); \
        unsigned b0 = cvt_pk_bf16(P[B_+4], P[B_+5]), b1 = cvt_pk_bf16(P[B_+6], P[B_+7]); \
        auto r0 = __builtin_amdgcn_permlane32_swap(a0, b0, false, false); auto r1 = __builtin_amdgcn_permlane32_swap(a1, b1, false, false); \
        u32x4 w = {r0[0], r1[0], r0[1], r1[1]}; OUT = __builtin_bit_cast(bf16x8, w); } while (0)
    PK4(p0, 0, pa0); PK4(p0, 8, pa1); PK4(p1, 0, pa2); PK4(p1, 8, pa3);
#undef PK4
}
__device__ __forceinline__ void swap32(float x, float& lo, float& hi) {
    auto rr = __builtin_amdgcn_permlane32_swap(__float_as_uint(x), __float_as_uint(x), false, false); lo = __uint_as_float(rr[0]); hi = __uint_as_float(rr[1]);
}

struct UnitDesc {
    const bf16* Q;
    const bf16* Kn; const bf16* Vn;
    const float* Kc; const float* Vc;
    int cpitch, npast;
    const float* cum; int cstride;
    bf16* O;
    int P0, nq, nk;
    float kmax;
};

template <int MODE, bool SAMPLE>
__device__ __forceinline__ void unit(LAS char* lds, const UnitDesc& D) {
    constexpr int TPS = 1, NSLOT = 2 * TPS;
    const int tid = otid(), wid = __builtin_amdgcn_readfirstlane(tid >> 6), lane = tid & 63, r32 = lane & 31, hi = lane >> 5;
    LAS char* V_lds = lds + L_V; LAS char* K_lds = lds + L_K; LAS float* bias_l = (LAS float*)(lds + L_BIAS);
    LAS float* ws = (LAS float*)(lds + L_WS) + wid * 64; LAS unsigned* flag = (LAS unsigned*)(lds + L_FLAG);
    const int sr = tid >> 4, sc = (tid & 15) * 8, vst0 = v_st(sr, sc), vst1 = v_st(32 + sr, sc), kws = KSWZ(sr, sc * 2);
    const unsigned vb0 = (unsigned)(uintptr_t)V_lds + v_rd_base(lane);
    const bool wact = wid * 32 < D.nq;
    int qrow = wid * 32 + r32; if (qrow >= D.nq) qrow = D.nq - 1;
    const int wmin = D.P0 + wid * 32, wmax = D.P0 + (wid * 32 + 31 < D.nq ? wid * 32 + 31 : D.nq - 1);
    const int pos = D.P0 + qrow;
    bf16x8 qr[8];
#pragma unroll
    for (int d0 = 0; d0 < 8; ++d0) qr[d0] = *(const bf16x8*)(D.Q + (size_t)qrow * DM + d0 * 16 + hi * 8);
    const int jt_hi = (D.P0 + D.nq - 1) >> 6, NTL = jt_hi + 1;
    float ck_ref = 0.f; if (MODE == 0) ck_ref = D.cum[(size_t)D.P0 * D.cstride];
    static_assert(PAST % 64 == 0 && DECS <= 64, "sample units: the newest tile holds exactly this launch's tokens");
    bf16x8 st_k0[TPS], st_k1[TPS], st_v0[TPS], st_v1[TPS]; float st_b[TPS];
    f32x4 sf_k[4], sf_v[4];
#define LOADG(i, jt_) do { const int k0_ = (jt_) * 64; \
        if constexpr (SAMPLE) { const float* pk_ = D.Kc + (size_t)(k0_ + sr) * D.cpitch + sc; const float* pv_ = D.Vc + (size_t)(k0_ + sr) * D.cpitch + sc; \
            sf_k[0] = *(const f32x4*)pk_; sf_k[1] = *(const f32x4*)(pk_ + 4); sf_k[2] = *(const f32x4*)(pk_ + (size_t)32 * D.cpitch); sf_k[3] = *(const f32x4*)(pk_ + (size_t)32 * D.cpitch + 4); \
            sf_v[0] = *(const f32x4*)pv_; sf_v[1] = *(const f32x4*)(pv_ + 4); sf_v[2] = *(const f32x4*)(pv_ + (size_t)32 * D.cpitch); sf_v[3] = *(const f32x4*)(pv_ + (size_t)32 * D.cpitch + 4); \
        } else { \
            st_k0[i] = *(const bf16x8*)(D.Kn + (size_t)(k0_ + sr) * DM + sc); st_k1[i] = *(const bf16x8*)(D.Kn + (size_t)(k0_ + 32 + sr) * DM + sc); \
            st_v0[i] = *(const bf16x8*)(D.Vn + (size_t)(k0_ + sr) * DM + sc); st_v1[i] = *(const bf16x8*)(D.Vn + (size_t)(k0_ + 32 + sr) * DM + sc); } \
        if (MODE == 0 && tid < 64) { const int kk_ = k0_ + tid; st_b[i] = D.cum[(size_t)(kk_ < D.nk ? kk_ : D.nk - 1) * D.cstride]; } } while (0)
#define WRITEL(i, slot_, cvt_) do { const int so_ = (slot_) * SHM; \
        if (SAMPLE && (cvt_)) { st_k0[i] = pack8(sf_k[0], sf_k[1]); st_k1[i] = pack8(sf_k[2], sf_k[3]); st_v0[i] = pack8(sf_v[0], sf_v[1]); st_v1[i] = pack8(sf_v[2], sf_v[3]); } \
        *(LAS bf16x8*)(K_lds + so_ + kws) = st_k0[i]; *(LAS bf16x8*)(K_lds + so_ + kws + 32 * 256) = st_k1[i]; \
        *(LAS bf16x8*)(V_lds + so_ + vst0) = st_v0[i]; *(LAS bf16x8*)(V_lds + so_ + vst1) = st_v1[i]; \
        if (MODE == 0 && tid < 64) bias_l[(slot_) * 64 + tid] = (ck_ref - st_b[i]) * RSCALE; } while (0)
    f32x16 o[4];
#pragma unroll
    for (int d = 0; d < 4; ++d)
#pragma unroll
        for (int r = 0; r < 16; ++r) o[d][r] = 0.f;
    float m_reg = -1e30f, l_reg = 0.f, R = 1.f;
    float qk_bound = 0.f;
    if (MODE == 0) { float s = 0.f;
#pragma unroll
        for (int d0 = 0; d0 < 8; ++d0)
#pragma unroll
            for (int e = 0; e < 8; ++e) { const float v = __uint_as_float(((unsigned)(unsigned short)qr[d0][e]) << 16); s += v * v; }
        float a, b; swap32(s, a, b); qk_bound = __builtin_sqrtf(a + b) * D.kmax * 1.0001f; }
    bool wdone = !wact;
    auto compute = [&](int t, int slot) {
        const int jt = jt_hi - t, kb_ = jt * 64;
        const bool need = wact && (MODE == 0 ? kb_ <= wmax : kb_ < wmax);
        if (!need || wdone) return;
        const bool domask = MODE == 0 ? (kb_ + 63 > wmin) : (kb_ + 63 >= wmin);
        const int dq = pos - kb_ - 4 * hi - (MODE == 1 ? 1 : 0);
        f32x16 p0, p1;
        if (MODE == 0) {
            LAS const float* bl = bias_l + slot * 64 + 4 * hi;
#pragma unroll
            for (int g = 0; g < 4; ++g) { const f32x4 b0 = *(LAS const f32x4*)(bl + 8 * g), b1 = *(LAS const f32x4*)(bl + 32 + 8 * g);
#pragma unroll
                for (int e = 0; e < 4; ++e) { p0[4 * g + e] = b0[e]; p1[4 * g + e] = b1[e]; } }
        } else {
#pragma unroll
            for (int r = 0; r < 16; ++r) { p0[r] = 0.f; p1[r] = 0.f; }
        }
        SBAR(); qkt(p0, p1, K_lds + slot * SHM, r32, hi, qr); SBAR();
        bf16x8 pa0, pa1, pa2, pa3;
        if (MODE == 0) {
            const float NEG = -__builtin_inff();
            if (domask) {
#pragma unroll
                for (int r = 0; r < 16; ++r) { const int c = (r & 3) + 8 * (r >> 2); if (dq - c < 0) p0[r] = NEG; if (dq - c - 32 < 0) p1[r] = NEG; }
            }
            float pmax = p0[0];
#pragma unroll
            for (int r = 1; r < 16; ++r) pmax = fmaxf(pmax, p0[r]);
#pragma unroll
            for (int r = 0; r < 16; ++r) pmax = fmaxf(pmax, p1[r]);
            { float a, b; swap32(pmax, a, b); pmax = fmaxf(a, b); }
            constexpr float C2 = SCALE * LOG2E;
            const float mn = fmaxf(m_reg, pmax), alpha = fexp2((m_reg - mn) * C2), mnL = -mn * C2; m_reg = mn;
            float ps = 0.f;
#pragma unroll
            for (int r = 0; r < 16; ++r) { p0[r] = fexp2(fmaf(p0[r], C2, mnL)); p1[r] = fexp2(fmaf(p1[r], C2, mnL)); ps += p0[r] + p1[r]; }
            { float a, b; swap32(ps, a, b); ps = a + b; }
            l_reg = l_reg * alpha + ps;
            if (__any(alpha < 1.f)) { if (hi == 0) ws[r32] = alpha; asm volatile("s_waitcnt lgkmcnt(0)" ::: "memory");
#pragma unroll
                for (int d_ = 0; d_ < 4; ++d_)
#pragma unroll
                    for (int r = 0; r < 16; ++r) o[d_][r] *= ws[crow(r, hi)];
                asm volatile("s_waitcnt lgkmcnt(0)" ::: "memory"); }
            wdone = D.kmax > 0.f && __all((qk_bound + bias_l[slot * 64] - m_reg) * C2 < -128.f);
        } else {
            constexpr float CZ = SCALE * LOG2E;
            f32x16 s0, s1;
#pragma unroll
            for (int r = 0; r < 16; ++r) {
                { const float e = fexp2(fminf(p0[r] * CZ, 126.f)), rr = __builtin_amdgcn_rcpf(1.f + e); s0[r] = rr; p0[r] = e * rr; }
                { const float e = fexp2(fminf(p1[r] * CZ, 126.f)), rr = __builtin_amdgcn_rcpf(1.f + e); s1[r] = rr; p1[r] = e * rr; }
            }
            if (domask) {
#pragma unroll
                for (int r = 0; r < 16; ++r) { const int c = (r & 3) + 8 * (r >> 2);
                    if (dq - c < 0) { s0[r] = 1.f; p0[r] = 0.f; } if (dq - c - 32 < 0) { s1[r] = 1.f; p1[r] = 0.f; } }
            }
            float glo[8], ghi[8];
#pragma unroll
            for (int g = 0; g < 4; ++g) { swap32((s0[4 * g] * s0[4 * g + 1]) * (s0[4 * g + 2] * s0[4 * g + 3]), glo[g], ghi[g]);
                                          swap32((s1[4 * g] * s1[4 * g + 1]) * (s1[4 * g + 2] * s1[4 * g + 3]), glo[4 + g], ghi[4 + g]); }
            float T = R;
#pragma unroll
            for (int m = 7; m >= 0; --m) {
                float run = hi ? T : T * ghi[m];
                if (m < 4) {
#pragma unroll
                    for (int e = 3; e >= 0; --e) { const float a = p0[4 * m + e] * run; run *= s0[4 * m + e]; p0[4 * m + e] = a; }
                } else {
#pragma unroll
                    for (int e = 3; e >= 0; --e) { const float a = p1[4 * (m - 4) + e] * run; run *= s1[4 * (m - 4) + e]; p1[4 * (m - 4) + e] = a; }
                }
                T *= glo[m] * ghi[m];
            }
            R = T;
            wdone = __all(R == 0.f);
        }
        pack_p(p0, p1, pa0, pa1, pa2, pa3);
        SBAR(); pv_tile(o, vb0 + slot * SHM, pa0, pa1, pa2, pa3); SBAR();
    };
#pragma unroll
    for (int i = 0; i < TPS; ++i) if (i < NTL) {
        if constexpr (SAMPLE) { const int ka = jt_hi * 64 + sr, kb = ka + 32; const bf16x8 z = (bf16x8){0, 0, 0, 0, 0, 0, 0, 0};
            st_k0[0] = ka < D.nk ? *(const bf16x8*)(D.Kn + (size_t)(ka - D.npast) * DM + sc) : z; st_v0[0] = ka < D.nk ? *(const bf16x8*)(D.Vn + (size_t)(ka - D.npast) * DM + sc) : z;
            st_k1[0] = kb < D.nk ? *(const bf16x8*)(D.Kn + (size_t)(kb - D.npast) * DM + sc) : z; st_v1[0] = kb < D.nk ? *(const bf16x8*)(D.Vn + (size_t)(kb - D.npast) * DM + sc) : z;
            if (MODE == 0 && tid < 64) { const int kk = jt_hi * 64 + tid; st_b[0] = D.cum[(size_t)(kk < D.nk ? kk : D.nk - 1) * D.cstride]; }
        } else LOADG(i, jt_hi - i); }
#pragma unroll
    for (int i = 0; i < TPS; ++i) if (i < NTL) WRITEL(i, i, false);
    __syncthreads();
#pragma unroll
    for (int i = 0; i < TPS; ++i) if (TPS + i < NTL) LOADG(i, jt_hi - TPS - i);
    int stg = 0;
    for (int t0 = 0; t0 < NTL; t0 += TPS, ++stg) {
#pragma unroll
        for (int i = 0; i < TPS; ++i) if (t0 + i < NTL) compute(t0 + i, (t0 + i) & (NSLOT - 1));
#pragma unroll
        for (int i = 0; i < TPS; ++i) if (t0 + TPS + i < NTL) WRITEL(i, (t0 + TPS + i) & (NSLOT - 1), true);
        if (lane == 0) flag[(stg & 1) * 8 + wid] = wdone ? 1u : 0u;
        __syncthreads();
        {
            unsigned all = 1u;
#pragma unroll
            for (int w = 0; w < 8; ++w) all &= flag[(stg & 1) * 8 + w];
            if (all) break;
        }
#pragma unroll
        for (int i = 0; i < TPS; ++i) if (t0 + 2 * TPS + i < NTL) LOADG(i, jt_hi - (t0 + 2 * TPS + i));
    }
#undef LOADG
#undef WRITEL
    if (wact) {
        float rli[16];
        if (MODE == 0) { if (hi == 0) ws[32 + r32] = l_reg; asm volatile("s_waitcnt lgkmcnt(0)" ::: "memory");
#pragma unroll
            for (int r = 0; r < 16; ++r) rli[r] = __builtin_amdgcn_rcpf(ws[32 + crow(r, hi)]); }
        bf16* Ow = D.O + (size_t)(wid * 32) * DM;
#pragma unroll
        for (int r = 0; r < 16; ++r) { const int orow = crow(r, hi);
#pragma unroll
            for (int d0 = 0; d0 < 4; ++d0) { const float v = MODE == 0 ? o[d0][r] * rli[r] : o[d0][r];
                const float vn = __shfl_xor(v, 1);
                if ((r32 & 1) == 0 && wid * 32 + orow < D.nq) *(unsigned*)(Ow + (size_t)orow * DM + d0 * 32 + r32) = cvt_pk_bf16(v, vn); } }
    }
    __syncthreads();
}

__device__ __forceinline__ void fox_sample_unit(LAS char* lds, const UnitDesc& D) {
    const int tid = otid(), wid = __builtin_amdgcn_readfirstlane(tid >> 6), lane = tid & 63, r32 = lane & 31, hi = lane >> 5;
    LAS char* Vw = lds + wid * 8192;
    LAS float* comb = (LAS float*)(lds + 65536);
    LAS float* ml = (LAS float*)(lds + L_BIAS);
    LAS float* ws = (LAS float*)(lds + L_WS) + wid * 64;
    const unsigned vb0 = (unsigned)(uintptr_t)Vw + v_rd_base(lane);
    const int qrow = r32 < D.nq ? r32 : D.nq - 1, pos = D.P0 + qrow;
    LAS char* Qs = lds + LDSCTL_OFF + 5120;
    if (tid < 256) { const int qr_ = tid >> 4, qc_ = tid & 15; const int qsrc = qr_ < D.nq ? qr_ : D.nq - 1;
        *(LAS bf16x8*)(Qs + qr_ * 272 + qc_ * 16) = *(const bf16x8*)(D.Q + (size_t)qsrc * DM + qc_ * 8); }
    __syncthreads();
    LAS const char* qsl = Qs + qrow * 272 + hi * 16;
    float qk_bound;
    { float s = 0.f;
#pragma unroll
      for (int d0 = 0; d0 < 8; ++d0) { const bf16x8 q_ = *(LAS const bf16x8*)(qsl + d0 * 32);
#pragma unroll
          for (int e = 0; e < 8; ++e) { const float v = __uint_as_float(((unsigned)(unsigned short)q_[e]) << 16); s += v * v; } }
      float a, b; swap32(s, a, b); qk_bound = __builtin_sqrtf(a + b) * D.kmax * 1.0001f; }
    const float ck_ref = D.cum[(size_t)D.P0 * D.cstride];
    const int NT32 = (D.nk + 31) >> 5;
    f32x16 o[4];
#pragma unroll
    for (int d = 0; d < 4; ++d)
#pragma unroll
        for (int r = 0; r < 16; ++r) o[d][r] = 0.f;
    float m_reg = -1e30f, l_reg = 0.f;
    constexpr float C2 = SCALE * LOG2E;
    const int vkey = lane >> 1, vcol = (lane & 1) * 64;
    for (int jt = NT32 - 1 - wid; jt >= 0; jt -= 8) {
        const int k0 = jt * 32;
        bf16x8 kf[8];
        const int kmy = k0 + r32;
        const float bmy = kmy < D.nk ? (ck_ref - D.cum[(size_t)kmy * D.cstride]) * RSCALE : 0.f;
        const float bnx = jt >= 8 ? (ck_ref - D.cum[(size_t)(k0 - 7 * 32 - 1) * D.cstride]) * RSCALE : 0.f;
        if (k0 >= D.npast) {
            const int kk = k0 + r32 - D.npast; const bf16x8 z = (bf16x8){0, 0, 0, 0, 0, 0, 0, 0};
#pragma unroll
            for (int d0 = 0; d0 < 8; ++d0) kf[d0] = k0 + r32 < D.nk ? *(const bf16x8*)(D.Kn + (size_t)kk * DM + d0 * 16 + hi * 8) : z;
            const int kv = k0 + vkey - D.npast;
#pragma unroll
            for (int j = 0; j < 8; ++j) { const bf16x8 v = k0 + vkey < D.nk ? *(const bf16x8*)(D.Vn + (size_t)kv * DM + vcol + j * 8) : z;
                *(LAS bf16x8*)(Vw + v_st(vkey, vcol + j * 8)) = v; }
        } else {
            const float* kp = D.Kc + (size_t)(k0 + r32) * D.cpitch + hi * 8; const float* vp = D.Vc + (size_t)(k0 + vkey) * D.cpitch + vcol;
            f32x4 kr[16], va[8], vb[8];
#pragma unroll
            for (int d0 = 0; d0 < 8; ++d0) { kr[2 * d0] = *(const f32x4*)(kp + d0 * 16); kr[2 * d0 + 1] = *(const f32x4*)(kp + d0 * 16 + 4); }
#pragma unroll
            for (int j = 0; j < 8; ++j) va[j] = *(const f32x4*)(vp + j * 4);
#pragma unroll
            for (int d0 = 0; d0 < 8; ++d0) kf[d0] = pack8(kr[2 * d0], kr[2 * d0 + 1]);
            SBAR();
#pragma unroll
            for (int j = 0; j < 8; ++j) vb[j] = *(const f32x4*)(vp + 32 + j * 4);
#pragma unroll
            for (int j = 0; j < 4; ++j) *(LAS bf16x8*)(Vw + v_st(vkey, vcol + j * 8)) = pack8(va[2 * j], va[2 * j + 1]);
#pragma unroll
            for (int j = 0; j < 4; ++j) *(LAS bf16x8*)(Vw + v_st(vkey, vcol + 32 + j * 8)) = pack8(vb[2 * j], vb[2 * j + 1]);
        }
        f32x16 p0;
#pragma unroll
        for (int r = 0; r < 16; ++r) p0[r] = __shfl(bmy, crow(r, hi));
        SBAR();
#pragma unroll
        for (int d0 = 0; d0 < 8; ++d0) p0 = __builtin_amdgcn_mfma_f32_32x32x16_bf16(kf[d0], *(LAS const bf16x8*)(qsl + d0 * 32), p0, 0, 0, 0);
        SBAR();
        if (k0 + 31 > D.P0) {
            const int dq = pos - k0 - 4 * hi; const float NEG = -__builtin_inff();
#pragma unroll
            for (int r = 0; r < 16; ++r) { const int c = (r & 3) + 8 * (r >> 2); if (dq - c < 0) p0[r] = NEG; }
        }
        float pmax = p0[0];
#pragma unroll
        for (int r = 1; r < 16; ++r) pmax = fmaxf(pmax, p0[r]);
        { float a, b; swap32(pmax, a, b); pmax = fmaxf(a, b); }
        const float mn = fmaxf(m_reg, pmax), alpha = fexp2((m_reg - mn) * C2), mnL = -mn * C2; m_reg = mn;
        float ps = 0.f;
#pragma unroll
        for (int r = 0; r < 16; ++r) { p0[r] = fexp2(fmaf(p0[r], C2, mnL)); ps += p0[r]; }
        { float a, b; swap32(ps, a, b); ps = a + b; }
        l_reg = l_reg * alpha + ps;
        if (__any(alpha < 1.f)) { if (hi == 0) ws[r32] = alpha; asm volatile("s_waitcnt lgkmcnt(0)" ::: "memory");
#pragma unroll
            for (int d_ = 0; d_ < 4; ++d_)
#pragma unroll
                for (int r = 0; r < 16; ++r) o[d_][r] *= ws[crow(r, hi)];
            asm volatile("s_waitcnt lgkmcnt(0)" ::: "memory"); }
        bf16x8 pa0, pa1;
        {
#define PK4(P, B_, OUT) do { unsigned a0 = cvt_pk_bf16(P[B_+0], P[B_+1]), a1 = cvt_pk_bf16(P[B_+2], P[B_+3]); \
        unsigned b0 = cvt_pk_bf16(P[B_+4], P[B_+5]), b1 = cvt_pk_bf16(P[B_+6], P[B_+7]); \
        auto r0 = __builtin_amdgcn_permlane32_swap(a0, b0, false, false); auto r1 = __builtin_amdgcn_permlane32_swap(a1, b1, false, false); \
        u32x4 w = {r0[0], r1[0], r0[1], r1[1]}; OUT = __builtin_bit_cast(bf16x8, w); } while (0)
            PK4(p0, 0, pa0); PK4(p0, 8, pa1);
#undef PK4
        }
        SBAR();
#define TRRD(dst, off) asm volatile("ds_read_b64_tr_b16 %0, %1 offset:%2" : "=&v"(dst) : "v"(vb0), "i"(off) : "memory")
#define PV_D0(d0) do { s16x4 l0, l1, h0, h1; constexpr int b_ = v_rd_off(d0, 0, 0); \
        TRRD(l0, b_); TRRD(h0, b_ + 2048); TRRD(l1, b_ + 4096); TRRD(h1, b_ + 6144); \
        asm volatile("s_waitcnt lgkmcnt(0)" ::: "memory"); SBAR(); \
        o[d0] = __builtin_amdgcn_mfma_f32_32x32x16_bf16(pa0, (bf16x8){l0[0], l0[1], l0[2], l0[3], h0[0], h0[1], h0[2], h0[3]}, o[d0], 0, 0, 0); \
        o[d0] = __builtin_amdgcn_mfma_f32_32x32x16_bf16(pa1, (bf16x8){l1[0], l1[1], l1[2], l1[3], h1[0], h1[1], h1[2], h1[3]}, o[d0], 0, 0, 0); } while (0)
        PV_D0(0); PV_D0(1); PV_D0(2); PV_D0(3);
#undef PV_D0
#undef TRRD
        SBAR();
        if (D.kmax > 0.f && jt >= 8 && __all((qk_bound + bnx - m_reg) * C2 < -128.f)) break;
    }
    if (hi == 0 && r32 < 16) { ml[(wid * 16 + r32) * 2] = m_reg; ml[(wid * 16 + r32) * 2 + 1] = l_reg; }
#pragma unroll
    for (int r = 0; r < 8; ++r) { const int row = crow(r, hi);
#pragma unroll
        for (int d0 = 0; d0 < 4; ++d0) comb[(wid * 16 + row) * 128 + d0 * 32 + r32] = o[d0][r]; }
    __syncthreads();
    {
        const int row = tid >> 5, c4 = (tid & 31) * 4;
        float M = -1e30f;
#pragma unroll
        for (int w = 0; w < 8; ++w) M = fmaxf(M, ml[(w * 16 + row) * 2]);
        f32x4 num = {0.f, 0.f, 0.f, 0.f}; float den = 0.f;
#pragma unroll
        for (int w = 0; w < 8; ++w) { const float sc_ = fexp2((ml[(w * 16 + row) * 2] - M) * C2);
            den += sc_ * ml[(w * 16 + row) * 2 + 1]; num += *(LAS const f32x4*)(comb + (w * 16 + row) * 128 + c4) * sc_; }
        const float rd = 1.f / den;
        if (row < D.nq) { const u32x2 wv = {cvt_pk_bf16(num[0] * rd, num[1] * rd), cvt_pk_bf16(num[2] * rd, num[3] * rd)}; *(u32x2*)(D.O + (size_t)row * DM + c4) = wv; }
    }
    __syncthreads();
}
}

struct Args { const float* in[21]; float* out; unsigned char* ws; };

__device__ __forceinline__ u32x4 pk8(const float* v) { u32x4 w = {cvt_pk_bf16(v[0], v[1]), cvt_pk_bf16(v[2], v[3]), cvt_pk_bf16(v[4], v[5]), cvt_pk_bf16(v[6], v[7])}; return w; }

template <int RM, bool GAIN>
__device__ __forceinline__ void conv_item(LAS unsigned char* lw, const float* W, int ldn, const float* gain, bf16* WT, int K, int item, int nblk, int lane_) {
    int lane = lane_; asm volatile("" : "+v"(lane));
    const int kb = __builtin_amdgcn_readfirstlane(item / nblk), nb = __builtin_amdgcn_readfirstlane(item % nblk), k0 = kb * 64, n = nb * 64 + lane;
    const float* rowp = W + (size_t)k0 * ldn + nb * 64;
    float v[64];
#pragma unroll
    for (int i = 0; i < 64; ++i) { v[i] = __builtin_nontemporal_load(rowp + lane); rowp += ldn; }
    if (GAIN) { const unsigned gv = __float_as_uint(gain[k0 + lane]);
#pragma unroll
        for (int i = 0; i < 64; ++i) v[i] *= __uint_as_float(__builtin_amdgcn_readlane(gv, i)); }
#pragma unroll
    for (int j = 0; j < 8; ++j) *(LAS u32x4*)(lw + lane * 144 + j * 16) = pk8(v + j * 8);
    const int ch = lane & 7;
#pragma unroll
    for (int i = 0; i < 8; ++i) { const int rn = i * 8 + (lane >> 3), nn = nb * 64 + rn;
        const int row = RM == 0 ? nn : ((nn >> 7) * 256 + (nn & 127) + (RM == 2 ? 128 : 0));
        *(u32x4*)(WT + (size_t)row * K + k0 + ch * 8) = *(LAS const u32x4*)(lw + rn * 144 + ch * 16); }
}

#define CAS __attribute__((address_space(4)))
__device__ __forceinline__ const void* karg(int i) { const CAS char* p = (const CAS char*)__builtin_amdgcn_kernarg_segment_ptr(); asm volatile("" : "+s"(p));
    const GAS void* g = (const GAS void*)*(const CAS unsigned long long*)(p + 8 * i); return (const void*)g; }
#define KIN(i) ((const float*)karg(i))
#define KOUT ((float*)karg(21))
#define KWS ((unsigned char*)karg(22))

struct MapF { const bf16* XB; const bf16* WF; __device__ void get(int t, const bf16*& a, const bf16*& b0, const bf16*& b1) const { a = XB + (size_t)t * 128 * DM; b0 = WF; b1 = WF; } };
struct EpiF { static constexpr bool TWO_STAGE = false; const float* ssq; const float* b_f; float* LF; float* o_p; float* o_s;
            __device__ void operator()(int t, int r, int c4, f32x4 v0, f32x4) const { if (c4 >= 8) return; const int row = t * 128 + r; const float rs = rs_of(ssq, row);
                f32x4 lf;
#pragma unroll
                for (int e = 0; e < 4; ++e) { const float z = v0[e] * rs + b_f[c4 + e]; lf[e] = fminf(z, 0.f) - __logf(1.f + __expf(-fabsf(z))); }
                *(f32x4*)(LF + (size_t)row * 8 + c4) = lf;
                if (row < SEQ) *(f32x4*)(o_p + (size_t)row * 8 + c4) = lf; else *(f32x4*)(o_s + (size_t)(row - SEQ) * 8 + c4) = lf; } };
struct MapS { const bf16* A; const bf16* W; __device__ void get(int t, const bf16*& a, const bf16*& b0, const bf16*& b1) const { a = A; b0 = W + (size_t)t * 16 * DM; b1 = b0; } };
struct EpiS { static constexpr bool TWO_STAGE = false; const float* ssq; float* U; bf16* QB; bf16* KB; bf16* VB; float* fk; float* fv;
            __device__ void operator()(int t, int r, int c4, f32x4 v0, f32x4) const { const int row = SEQ + r, col = t * 16 + c4, sec = col >> 10, c = col & 1023; const f32x4 v = v0 * rs_of(ssq, row);
                const u32x2 w = {cvt_pk_bf16(v[0], v[1]), cvt_pk_bf16(v[2], v[3])};
                if (sec == 0) *(f32x4*)(U + (size_t)row * PW + c) = v;
                else if (sec == 1) *(u32x2*)(QB + (size_t)row * DM + c) = w;
                else if (sec == 2) { *(f32x4*)(fk + (size_t)r * FW + c) = v; *(u32x2*)(KB + (size_t)row * DM + c) = w; }
                else { *(f32x4*)(fv + (size_t)r * FW + c) = v; *(u32x2*)(VB + (size_t)row * DM + c) = w; } } };
struct MapP { const bf16* A; const bf16* W; __device__ void get(int t, const bf16*& a, const bf16*& b0, const bf16*& b1) const { a = A + (t >> 4) * 256; b0 = W + (size_t)t * 16 * 256; b1 = b0; } };
struct EpiP { static constexpr bool TWO_STAGE = false; const float* pscale; bf16* CAT;
            __device__ void operator()(int t, int r, int c4, f32x4 v0, f32x4) const { const int col = t * 16 + c4; const f32x4 v = v0 * *(const f32x4*)(pscale + col);
                const u32x2 w = {cvt_pk_bf16(v[0], v[1]), cvt_pk_bf16(v[2], v[3])}; *(u32x2*)(CAT + (size_t)(SEQ + r) * DM + col) = w; } };
struct MapW { const bf16* A; const bf16* W; int K; __device__ void get(int t, const bf16*& a, const bf16*& b0, const bf16*& b1) const { a = A; b0 = W + (size_t)t * 16 * K; b1 = b0; } };
struct MapGU { const bf16* A; const bf16* W; __device__ void get(int t, const bf16*& a, const bf16*& b0, const bf16*& b1) const { a = A; b0 = W + ((size_t)(t >> 3) * 256 + (t & 7) * 16) * DM; b1 = b0 + (size_t)128 * DM; } };
__device__ __forceinline__ f32x4 ld_hilo4(const bf16* hi, const bf16* lo) { const s16x4 h = *(const s16x4*)hi; f32x4 r;
#pragma unroll
    for (int e = 0; e < 4; ++e) r[e] = bf2f(h[e]);
    if (RES_LO) { const s16x4 l = *(const s16x4*)lo;
#pragma unroll
        for (int e = 0; e < 4; ++e) r[e] += bf2f(l[e]); }
    return r; }
template <bool RESF32> struct EpiResS { static constexpr bool TWO_STAGE = false; const float* resf; bf16* HB; bf16* HL; float* ssq;
    __device__ void operator()(int t, int r, int c4, f32x4 v0, f32x4) const { const size_t o = (size_t)r * DM + t * 16 + c4;
        const f32x4 v = v0 + (RESF32 ? *(const f32x4*)(resf + o) : ld_hilo4(HB + o, HL + o));
        const u32x2 wh = {cvt_pk_bf16(v[0], v[1]), cvt_pk_bf16(v[2], v[3])}; *(u32x2*)(HB + o) = wh;
        const s16x4 hh = __builtin_bit_cast(s16x4, wh); f32x4 rr;
#pragma unroll
        for (int e = 0; e < 4; ++e) rr[e] = v[e] - bf2f(hh[e]);
        if (RES_LO) { const u32x2 wl = {cvt_pk_bf16(rr[0], rr[1]), cvt_pk_bf16(rr[2], rr[3])}; *(u32x2*)(HL + o) = wl; }
        float s = (v[0] * v[0] + v[1] * v[1]) + (v[2] * v[2] + v[3] * v[3]); s += __shfl_xor(s, 16); s += __shfl_xor(s, 32);
        if (c4 == 0) atomicAdd(ssq + r, s); } };
struct EpiResSFinal { static constexpr bool TWO_STAGE = true;
    const bf16* HB; const bf16* HL; float* Y; const float* lnf; float* ssq; unsigned* cnt; unsigned* tmo; unsigned need;
    __device__ f32x4 stage1(int t, int r, int c4, f32x4 v0) const { const size_t o = (size_t)r * DM + t * 16 + c4; const f32x4 v = v0 + ld_hilo4(HB + o, HL + o);
        float s = (v[0] * v[0] + v[1] * v[1]) + (v[2] * v[2] + v[3] * v[3]); s += __shfl_xor(s, 16); s += __shfl_xor(s, 32);
        if (c4 == 0) atomicAdd(ssq + r, s);
        return v; }
    __device__ void wait_all() const { asm volatile("s_waitcnt vmcnt(0)" ::: "memory"); __syncthreads(); if (threadIdx.x == 0) wait_count(cnt, need, tmo); __syncthreads(); }
    __device__ void stage2(int t, int r, int c4, f32x4 v) const { const size_t o = (size_t)r * DM + t * 16 + c4;
        const float rs = __builtin_amdgcn_rsqf(__hip_atomic_load(ssq + r, __ATOMIC_RELAXED, __HIP_MEMORY_SCOPE_AGENT) * (1.f / DM) + EPS);
        *(f32x4*)(Y + o) = v * rs * *(const f32x4*)(lnf + t * 16 + c4); } };
struct EpiGUS { static constexpr bool TWO_STAGE = false; const float* ssq; bf16* ACT;
        __device__ void operator()(int t, int r, int c4, f32x4 g, f32x4 u) const { const float rs = rs_of(ssq, r); f32x4 a;
#pragma unroll
            for (int e = 0; e < 4; ++e) a[e] = swiglu1(g[e] * rs, u[e] * rs);
            const u32x2 w = {cvt_pk_bf16(a[0], a[1]), cvt_pk_bf16(a[2], a[3])}; *(u32x2*)(ACT + (size_t)r * DFF + t * 16 + c4) = w; } };
struct EpiQS { static constexpr bool TWO_STAGE = false; const float* ssq; bf16* QB; bf16* KB; bf16* VB; float* sk; float* sv;
            __device__ void operator()(int t, int r, int c4, f32x4 v0, f32x4) const { const int row = SEQ + r, col = t * 16 + c4, sec = col >> 11, c = col & 2047; const f32x4 v = v0 * rs_of(ssq, row);
                const u32x2 w = {cvt_pk_bf16(v[0], v[1]), cvt_pk_bf16(v[2], v[3])};
                if (sec == 0) *(u32x2*)(QB + (size_t)row * DM + c) = w;
                else if (sec == 1) { *(f32x4*)(sk + (size_t)r * DM + c) = v; *(u32x2*)(KB + (size_t)row * DM + c) = w; }
                else { *(f32x4*)(sv + (size_t)r * DM + c) = v; *(u32x2*)(VB + (size_t)row * DM + c) = w; } } };

struct MapW2 { const bf16* A; const bf16* W; int K; __device__ void get(int t, const bf16*& a, const bf16*& b0, const bf16*& b1) const { a = A; b0 = W + (size_t)t * 32 * K; b1 = b0 + (size_t)16 * K; } };
template <class E> struct Epi2 { static constexpr bool TWO_STAGE = false; E e; __device__ void operator()(int t, int r, int c4, f32x4 v0, f32x4 v1) const { e(2 * t, r, c4, v0, v0); e(2 * t + 1, r, c4, v1, v1); } };

#define x_p KIN(0)
#define x_s KIN(1)
#define cache_pool KIN(2)
#define c_fk KIN(3)
#define c_fv KIN(4)
#define c_flf KIN(5)
#define c_sk KIN(6)
#define c_sv KIN(7)
#define ln_mix KIN(8)
#define w_in KIN(9)
#define b_f KIN(10)
#define w_pool KIN(11)
#define pscale KIN(12)
#define w_out0 KIN(13)
#define w_qkv KIN(14)
#define w_out1 KIN(15)
#define ln_ffn KIN(16)
#define w_gate KIN(17)
#define w_up KIN(18)
#define w_down KIN(19)
#define ln_final KIN(20)
#define out KOUT
#define WIN ((bf16*)(KWS + WS_WIN))
#define WF ((bf16*)(KWS + WS_WF))
#define WPOOL ((bf16*)(KWS + WS_WPOOL))
#define WOUT0 ((bf16*)(KWS + WS_WOUT0))
#define WGU0 ((bf16*)(KWS + WS_WGU0))
#define WDN0 ((bf16*)(KWS + WS_WDN0))
#define WQKV ((bf16*)(KWS + WS_WQKV))
#define WOUT1 ((bf16*)(KWS + WS_WOUT1))
#define WGU1 ((bf16*)(KWS + WS_WGU1))
#define WDN1 ((bf16*)(KWS + WS_WDN1))
#define XB ((bf16*)(KWS + WS_HB))
#define U ((float*)(KWS + WS_U))
#define UBF ((bf16*)(KWS + WS_U))
#define QB ((bf16*)(KWS + WS_QB))
#define KB ((bf16*)(KWS + WS_KB))
#define VB ((bf16*)(KWS + WS_VB))
#define DBF ((bf16*)(KWS + WS_DB))
#define CAT ((bf16*)(KWS + WS_CAT))
#define HL ((bf16*)(KWS + WS_H))
#define HB ((bf16*)(KWS + WS_HB))
#define ACT ((bf16*)(KWS + WS_ACT))
#define LF ((float*)(KWS + WS_LF))
#define CUMP ((float*)(KWS + WS_CUMP))
#define CUMS ((float*)(KWS + WS_CUMS))
#define ssq ((float*)(KWS + WS_CTL) + CW_SSQ)
#define SCRH ((float*)(KWS + WS_SCRH))
#define SCRHB ((bf16*)(KWS + WS_SCRHB))
template <int Q>
__device__ __forceinline__ void drain_queue(LAS unsigned char* lds, volatile LAS unsigned* MISC, gu32* ctl, int tid, int wave, int lane) {
    constexpr int I_SQ = (DM / 64) * (DM / 64), I_FF = (DM / 64) * (DFF / 64), I_QKV = (DM / 64) * (3 * DM / 64);
    constexpr int TOT = Q == 0 ? I_SQ + 2 * I_FF : (Q == 1 ? I_FF + I_QKV + I_SQ : (Q == 3 ? 2 * I_FF : I_FF));
    unsigned* qh = (unsigned*)(ctl + CW_QHEAD + 64 * Q);
    __syncthreads();
    for (int par = 0;; par ^= 1) {
        if (tid == 0) MISC[16 + par] = __hip_atomic_fetch_add(qh, 8u, __ATOMIC_RELAXED, __HIP_MEMORY_SCOPE_AGENT);
        __syncthreads();
        const int base = (int)MISC[16 + par];
        if (base >= TOT) break;
        int it_ = base + wave; bool done_ = it_ >= TOT;
#define DCONV(RM, GN, W, ldn, N, gain, WT, K) if (!done_) { const int nblk = (N) / 64, nit = ((K) / 64) * nblk; if (it_ < nit) { conv_item<RM, GN>(lds + wave * 9216, W, ldn, gain, WT, K, it_, nblk, lane); done_ = true; } else it_ -= nit; }
        if constexpr (Q == 0) {
            DCONV(0, false, w_out0, DM, DM, nullptr, WOUT0, DM)
            DCONV(1, true, w_gate, DFF, DFF, ln_ffn, WGU0, DM)
            DCONV(2, true, w_up, DFF, DFF, ln_ffn, WGU0, DM)
        } else if constexpr (Q == 1) {
            DCONV(0, false, w_down, DM, DM, nullptr, WDN0, DFF)
            DCONV(0, true, w_qkv, 3 * DM, 3 * DM, ln_mix + DM, WQKV, DM)
            DCONV(0, false, w_out1, DM, DM, nullptr, WOUT1, DM)
        } else if constexpr (Q == 3) {
            DCONV(1, true, w_gate + (size_t)DM * DFF, DFF, DFF, ln_ffn + DM, WGU1, DM)
            DCONV(2, true, w_up + (size_t)DM * DFF, DFF, DFF, ln_ffn + DM, WGU1, DM)
        } else {
            DCONV(0, false, w_down + (size_t)DFF * DM, DM, DM, nullptr, WDN1, DFF)
        }
#undef DCONV
    }
}
constexpr int XI_ELEMS = 4096, XI_TOT = (SEQ / 256) * (128 * DM / XI_ELEMS);
__device__ __forceinline__ void drain_expand(volatile LAS unsigned* MISC, gu32* ctl, int tid, int wave, int lane) {
    unsigned* qh = (unsigned*)(ctl + CW_QHEAD + 64 * 4);
    __syncthreads();
    for (int par = 0;; par ^= 1) {
        if (tid == 0) MISC[20 + par] = __hip_atomic_fetch_add(qh, 8u, __ATOMIC_RELAXED, __HIP_MEMORY_SCOPE_AGENT);
        __syncthreads();
        const int base = (int)MISC[20 + par];
        if (base >= XI_TOT) break;
        const int it = base + wave; const size_t e0 = (size_t)(it >> 6) * 256 * DM + (size_t)(it & 63) * XI_ELEMS;
        const bf16* src = VB + e0; float* dst = out + O_SVP + e0;
        u32x2 v[16];
#pragma unroll
        for (int j = 0; j < 16; ++j) v[j] = *(const u32x2*)(src + (j * 64 + lane) * 4);
#pragma unroll
        for (int j = 0; j < 16; ++j) { const f32x4 f = {__uint_as_float(v[j][0] << 16), __uint_as_float(v[j][0] & 0xffff0000u), __uint_as_float(v[j][1] << 16), __uint_as_float(v[j][1] & 0xffff0000u)};
            *(f32x4*)(dst + (j * 64 + lane) * 4) = f; }
    }
}
__global__ void __launch_bounds__(NT, 2) fwd(Args args) {
    extern __shared__ __attribute__((aligned(16))) unsigned char lds_raw[];
    LAS unsigned char* lds = (LAS unsigned char*)lds_raw;
    volatile LAS unsigned* MISC = (volatile LAS unsigned*)(lds + MISC_OFF);
    const int tid = otid(), lane = tid & 63, wave = __builtin_amdgcn_readfirstlane(tid >> 6);
    const int G = gridDim.x, bx = blockIdx.x;
    const int vcu = (G % 8 == 0) ? (bx % 8) * (G / 8) + bx / 8 : bx;
    gu32* ctl = (gu32*)(KWS + WS_CTL);
    for (int u = tid; u < (LDS_BYTES - LDSCTL_OFF) / 4; u += NT) ((LAS unsigned*)(lds + LDSCTL_OFF))[u] = 0u;
    __syncthreads();
    XcdBarrier bar = xcd_barrier_post((unsigned*)(ctl + CW_BAR), MISC + 8);

    const int gw = vcu * NWAVES + wave, NGW = G * NWAVES;

    REP(0) {
        int it = gw;
#define CONV(RM, GN, W, ldn, N, gain, WT, K) { const int nblk = (N) / 64, nit = ((K) / 64) * nblk; const float* W_ = W; const float* g_ = gain; bf16* WT_ = WT; for (; it < nit; it += NGW) conv_item<RM, GN>(lds + wave * 9216, W_, ldn, g_, WT_, K, it, nblk, lane); it -= nit; }
        CONV(0, true, w_in, INAB, 4096, ln_mix, WIN, DM)
#pragma unroll 1
        for (int g = 0; g < 4; ++g) CONV(0, false, w_pool + (size_t)g * 65536, 256, 256, nullptr, WPOOL + (size_t)g * 65536, 256)
#undef CONV
        for (int i = bx * NT + tid; i < 16 * DM; i += G * NT) { const int j = i / DM, k = i % DM; const float v = j < 8 ? ln_mix[k] * w_in[(size_t)k * INAB + 4096 + j] : 0.f; WF[i] = (bf16)(cvt_pk_bf16(v, 0.f) & 0xffffu); }
        for (int m = gw; m < MP; m += NGW) {
            const float* xr = m < SEQ ? x_p + (size_t)m * DM : x_s + (size_t)(m - SEQ) * DM;
            f32x4 v[8]; float s = 0.f;
#pragma unroll
            for (int j = 0; j < 8; ++j) { v[j] = *(const f32x4*)(xr + (lane + 64 * j) * 4); s += (v[j][0] * v[j][0] + v[j][1] * v[j][1]) + (v[j][2] * v[j][2] + v[j][3] * v[j][3]); }
            s = wave_sum(s);
            if (lane == 0) ssq[m] = s;
#pragma unroll
            for (int j = 0; j < 8; ++j) { u32x2 w = {cvt_pk_bf16(v[j][0], v[j][1]), cvt_pk_bf16(v[j][2], v[j][3])}; *(u32x2*)(XB + (size_t)m * DM + (lane + 64 * j) * 4) = w; }
        }
    }
    {
        const int p = tid >> 1, hf = tid & 1, hd = p & 7, rofs = p >> 3;
        unsigned* kmx = (unsigned*)(ctl + CW_KMAX);
        const int NIT = DECB * PAST / 32, ipw = (NIT + G - 1) / G, i0 = bx * ipw, i1 = i0 + ipw < NIT ? i0 + ipw : NIT;
        float smax = 0.f; int bcur = -1;
        for (int it = i0; it < i1; ++it) {
            const int b = it / (PAST / 32);
            if (b != bcur && bcur >= 0) { wg_max8((LAS float*)lds, smax, lane, wave, tid, kmx + 8 + bcur * 8); smax = 0.f; }
            bcur = b;
            const int row = it * 32 + rofs; const float* kp = c_fk + (size_t)row * FW + hd * HD + hf * 64;
            f32x4 v[16]; float s = 0.f;
#pragma unroll
            for (int j = 0; j < 16; ++j) v[j] = *(const f32x4*)(kp + j * 4);
#pragma unroll
            for (int j = 0; j < 16; ++j) s += (v[j][0] * v[j][0] + v[j][1] * v[j][1]) + (v[j][2] * v[j][2] + v[j][3] * v[j][3]);
            s += __shfl_xor(s, 1); s = fmaxf(s, __shfl_xor(s, 16)); s = fmaxf(s, __shfl_xor(s, 32));
            smax = fmaxf(smax, s);
        }
        if (bcur >= 0) wg_max8((LAS float*)lds, smax, lane, wave, tid, kmx + 8 + bcur * 8);
    }
    xcd_barrier(bar);

    REP(1) {
        pg8::Gemm g{XB, WIN, DM, DM, DM, 0}; EpiIn E{ssq, UBF, out + O_POOLP, QB, KB, VB, out + O_FKP, out + O_FVP};
        pg8::BalancedOrder S{2, bx, G}; pg8::gemm_phase<EpiIn, pg8::BalancedOrder, true>(lds, g, S, E);
    }
    REP(2) {


        small_gemm<1>(lds, MP / 128, DM, DM, DM, MapF{XB, WF}, EpiF{ssq, b_f, LF, out + O_FLFP, out + O_FLFS}, G, (bx + G / 2) % G);
    }
    REP(2) {


        small_gemm<2>(lds, 128, DM, DM, DM, MapW2{XB + (size_t)SEQ * DM, WIN, DM}, Epi2<EpiS>{EpiS{ssq, U, QB, KB, VB, out + O_FKS, out + O_FVS}}, G, bx);
    }
    xcd_barrier(bar);

    REP(4) {
        const int c0 = 4 * (tid & 255), grp = __builtin_amdgcn_readfirstlane((tid >> 6) & 3), w = 2 << grp, hlf = __builtin_amdgcn_readfirstlane(tid >> 8);
        for (int pit = bx; pit < (512 + DECB) / 2; pit += G) {
            const int it = 2 * pit + hlf;
            const bool smp = it >= 512; const int b = it - 512;
            const int r0 = smp ? 0 : it * 16, base = smp ? SEQ + b * DECS : 0;
            const float* ub = U + (size_t)base * PW + c0;
            const float* pre = cache_pool + (size_t)(smp ? b : 0) * 15 * PW + c0;
            f32x4 a[31], u[16];
            if (smp) {
#pragma unroll
                for (int i = 0; i < 31; ++i) { const int j = i - 15;
                    if (j >= 0) a[i] = *(const f32x4*)(ub + (size_t)j * PW);
                    else a[i] = *(const f32x4*)(pre + (size_t)(15 + j) * PW); }
            } else {
                const bf16* ubb = UBF + c0; u32x2 ab[31];
#pragma unroll
                for (int i = 0; i < 31; ++i) { const int j = r0 - 15 + i; ab[i] = j >= 0 ? *(const u32x2*)(ubb + (size_t)j * PW) : (u32x2){0u, 0u}; }
#pragma unroll
                for (int i = 0; i < 31; ++i) a[i] = (f32x4){__uint_as_float(ab[i][0] << 16), __uint_as_float(ab[i][0] & 0xffff0000u), __uint_as_float(ab[i][1] << 16), __uint_as_float(ab[i][1] & 0xffff0000u)};
            }
#pragma unroll
            for (int k = 0; k < 16; ++k) u[k] = a[15 + k];
#pragma unroll
            for (int i = 30; i >= 1; --i) a[i] += a[i - 1];
            if (w >= 4) {
#pragma unroll
                for (int i = 30; i >= 3; --i) a[i] += a[i - 2]; }
            if (w >= 8) {
#pragma unroll
                for (int i = 30; i >= 7; --i) a[i] += a[i - 4]; }
            if (w >= 16) {
#pragma unroll
                for (int i = 30; i >= 15; --i) a[i] += a[i - 8]; }
#pragma unroll
            for (int k = 0; k < 16; ++k) { const int t = r0 + k;
                const float cnt = smp ? (float)w : (float)(t + 1 < w ? t + 1 : w);
                const f32x4 d = a[15 + k] * (1.f / cnt) - u[k];
                *(u32x2*)(DBF + (size_t)(base + t) * PW + c0) = (u32x2){cvt_pk_bf16(d[0], d[1]), cvt_pk_bf16(d[2], d[3])}; }
        }
        for (int i = bx * NT + tid; i < DECB * 15 * (PW / 4); i += G * NT) {
            const int q = i / (PW / 4), c4 = (i % (PW / 4)) * 4, b = q / 15, j = q % 15;
            *(f32x4*)(out + O_POOLS + (size_t)q * PW + c4) = *(const f32x4*)(U + (size_t)(SEQ + b * DECS + 1 + j) * PW + c4);
        }
        {
            const int p = tid >> 1, hf = tid & 1, hd = p & 7, rofs = p >> 3;
            unsigned* kmx = (unsigned*)(ctl + CW_KMAX);
            const int NSC = SEQ / 1024 + DECB * ((NKS + 1023) / 1024), GK = G > 2 * NSC ? G - NSC : G;
            for (int it = (G > 2 * NSC && bx >= GK) ? (1 << 30) : (bx + GK - 8) % GK; it < MP / 64; it += GK) {
                bf16x8 v[2][8];
#pragma unroll
                for (int r2 = 0; r2 < 2; ++r2) { const bf16* kp = KB + (size_t)(it * 64 + r2 * 32 + rofs) * DM + hd * HD + hf * 64;
#pragma unroll
                    for (int j = 0; j < 8; ++j) v[r2][j] = *(const bf16x8*)(kp + j * 8); }
                float sm[2];
#pragma unroll
                for (int r2 = 0; r2 < 2; ++r2) { float s = 0.f;
#pragma unroll
                    for (int j = 0; j < 8; ++j)
#pragma unroll
                        for (int e = 0; e < 8; ++e) { const float f = __uint_as_float(((unsigned)(unsigned short)v[r2][j][e]) << 16); s += f * f; }
                    s += __shfl_xor(s, 1); s = fmaxf(s, __shfl_xor(s, 16)); s = fmaxf(s, __shfl_xor(s, 32)); sm[r2] = s; }
                if (it * 64 < SEQ) wg_max8((LAS float*)lds, fmaxf(sm[0], sm[1]), lane, wave, tid, kmx);
                else {
#pragma unroll
                    for (int r2 = 0; r2 < 2; ++r2) { const int row = it * 64 + r2 * 32 + rofs;
                        if ((lane & 0x31) == 0) atomicMax(kmx + 8 + ((row - SEQ) / DECS) * 8 + hd, __float_as_uint(sm[r2])); } }
            }
            __syncthreads();
        }
        {
            constexpr int SPT = 2, SIT = NT * SPT, NIP = SEQ / SIT, NIS = (NKS + SIT - 1) / SIT, NPRE = (NIP > NIS ? NIP : NIS) - 1;
            LAS double* sc = (LAS double*)lds;
            for (int it = G - 1 - bx; it < NIP + DECB * NIS; it += G) {
                const bool smp = it >= NIP; const int b = smp ? (it - NIP) / NIS : 0, r = smp ? (it - NIP) % NIS : it, n = smp ? NKS : SEQ;
                f32x4 v[NPRE + 1][SPT][2];
#pragma unroll
                for (int q = 0; q <= NPRE; ++q) { const int rr = (q < NPRE && q < r) ? q : r;
#pragma unroll
                    for (int j = 0; j < SPT; ++j) { int p = rr * SIT + tid * SPT + j; p = p < n ? p : n - 1;
                        const float* rp = !smp ? LF + (size_t)p * 8 : (p < PAST ? c_flf + ((size_t)b * PAST + p) * FH : LF + (size_t)(SEQ + b * DECS + p - PAST) * 8);
                        v[q][j][0] = *(const f32x4*)rp; v[q][j][1] = *(const f32x4*)(rp + 4); } }
                __builtin_amdgcn_sched_barrier(0);
                double pre[8], run[8], loc[SPT][8];
#pragma unroll
                for (int e = 0; e < 8; ++e) { pre[e] = 0.0; run[e] = 0.0; }
#pragma unroll
                for (int q = 0; q < NPRE; ++q) if (q < r) {
#pragma unroll
                    for (int j = 0; j < SPT; ++j)
#pragma unroll
                        for (int e = 0; e < 8; ++e) pre[e] += (double)v[q][j][e >> 2][e & 3]; }
#pragma unroll
                for (int j = 0; j < SPT; ++j) { const bool ok = r * SIT + tid * SPT + j < n;
#pragma unroll
                    for (int e = 0; e < 8; ++e) { run[e] += ok ? (double)v[NPRE][j][e >> 2][e & 3] : 0.0; loc[j][e] = run[e]; } }
                LAS double* sT = (LAS double*)lds; LAS double* sP = sT + NT * 8; LAS double* sW = sP + NT * 8;
#pragma unroll
                for (int e = 0; e < 8; ++e) { sT[tid * 8 + e] = run[e]; sP[tid * 8 + e] = pre[e]; }
                __syncthreads();
                { const int e = tid & 7, seg = tid >> 3; double acc = 0.0, accp = 0.0, ex[8];
#pragma unroll
                    for (int k = 0; k < 8; ++k) { ex[k] = acc; acc += sT[(seg * 8 + k) * 8 + e]; accp += sP[(seg * 8 + k) * 8 + e]; }
                    double inc = acc;
#pragma unroll
                    for (int o = 8; o < 64; o <<= 1) { const double y = __shfl_up(inc, o); if (lane >= o) inc += y; accp += __shfl_xor(accp, o); }
                    if (lane >= 56) { sW[wave * 8 + e] = inc; sW[64 + wave * 8 + e] = accp; }
                    __syncthreads();
                    double base = inc - acc;
                    for (int k = 0; k < 8; ++k) { base += sW[64 + k * 8 + e]; if (k < wave) base += sW[k * 8 + e]; }
#pragma unroll
                    for (int k = 0; k < 8; ++k) sT[(seg * 8 + k) * 8 + e] = base + ex[k]; }
                __syncthreads();
#pragma unroll
                for (int j = 0; j < SPT; ++j) { const int p = r * SIT + tid * SPT + j;
                    if (p < n) { float* op = !smp ? CUMP + (size_t)p * 8 : CUMS + ((size_t)b * NKS + p) * 8; f32x4 o0, o1;
#pragma unroll
                        for (int e = 0; e < 4; ++e) { o0[e] = (float)(sT[tid * 8 + e] + loc[j][e]); o1[e] = (float)(sT[tid * 8 + 4 + e] + loc[j][4 + e]); }
                        *(f32x4*)op = o0; *(f32x4*)(op + 4) = o1; } }
                __syncthreads();
            }
        }
    }
    xcd_barrier(bar);

    REP(5) {
        pg8::Gemm g{DBF, WPOOL, PW, 256, 256, 256}; pg8::StaticOrder S; S.init(SEQ / 256, 4, G, bx);
        EpiPool E{pscale, CAT};
        pg8::gemm_phase<EpiPool, pg8::StaticOrder, true>(lds, g, S, E);
    }
    REP(5) {


        small_gemm<1>(lds, 64, PW, 256, 256, MapP{DBF + (size_t)SEQ * PW, WPOOL}, EpiP{pscale, CAT}, G, bx);
    }
    REP(7) {
        for (int uix = bx; uix < 256; uix += G) {
            att::UnitDesc D; const int h = uix & 7, qb = 31 - (uix >> 3);
            D.Q = QB + (size_t)qb * 256 * DM + h * HD; D.Kn = KB + h * HD; D.Vn = VB + h * HD; D.Kc = nullptr; D.Vc = nullptr; D.cpitch = 0; D.npast = 0;
            D.cum = CUMP + h; D.cstride = 8; D.O = CAT + (size_t)qb * 256 * DM + FW + h * HD; D.P0 = qb * 256; D.nq = 256; D.nk = qb * 256 + 256;
            D.kmax = __builtin_sqrtf(__uint_as_float(ctl[CW_KMAX + h]));
            att::unit<0, false>((LAS char*)lds, D);
        }
        for (int par = 0;; par ^= 1) {
            if (tid == 0) MISC[18 + par] = __hip_atomic_fetch_add((unsigned*)(ctl + CW_SHEAD) + (rep_ ? 64 : 0), 1u, __ATOMIC_RELAXED, __HIP_MEMORY_SCOPE_AGENT);
            __syncthreads();
            const int sx = (int)MISC[18 + par];
            if (sx >= DECB * FH) break;
            att::UnitDesc D; const int b = sx / FH, h = sx % FH;
            D.Q = QB + (size_t)(SEQ + b * DECS) * DM + h * HD; D.Kn = KB + (size_t)(SEQ + b * DECS) * DM + h * HD; D.Vn = VB + (size_t)(SEQ + b * DECS) * DM + h * HD;
            D.Kc = c_fk + (size_t)b * PAST * FW + h * HD; D.Vc = c_fv + (size_t)b * PAST * FW + h * HD; D.cpitch = FW; D.npast = PAST;
            D.cum = CUMS + (size_t)b * NKS * 8 + h; D.cstride = 8; D.O = CAT + (size_t)(SEQ + b * DECS) * DM + FW + h * HD; D.P0 = PAST; D.nq = DECS; D.nk = NKS;
            D.kmax = __builtin_sqrtf(__uint_as_float(ctl[CW_KMAX + 8 + b * 8 + h])) * 1.005f;
            att::fox_sample_unit((LAS char*)lds, D);
        }
    }
    drain_queue<0>(lds, MISC, ctl, tid, wave, lane);
    xcd_barrier(bar);


#define MLP_BLOCK(WOUT, WGU, WDN, RF32, RES_P, RES_S, SSQ_MID, SSQ_OUT, LAST) \
    {   pg8::Gemm g{CAT, WOUT, DM, DM, DM, 0}; pg8::StaticOrder S; S.init(SEQ / 256, DM / 256, G, bx); \
        EpiRes<RF32> E{RES_P, HB, HL, SSQ_MID}; pg8::gemm_phase<EpiRes<RF32>, pg8::StaticOrder, true>(lds, g, S, E); \
        small_gemm_t<1, 4>(lds, DM / 8, DM, DM, DM, MapW{CAT + (size_t)SEQ * DM, WOUT, DM}, EpiResS<RF32>{RES_S, HB + (size_t)SEQ * DM, HL + (size_t)SEQ * DM, SSQ_MID + SEQ}, G, bx); } \
    xcd_barrier(bar); \
    REP(9) {   pg8::Gemm g{HB, WGU, DM, DM, DM, 0}; pg8::StaticOrder S; S.init(MPAD / 256  , 2 * DFF / 256, G, bx); \
        EpiGU E{SSQ_MID, ACT}; pg8::gemm_phase<EpiGU, pg8::StaticOrder, true>(lds, g, S, E); } \
    if (LAST) { drain_queue<2>(lds, MISC, ctl, tid, wave, lane); drain_expand(MISC, ctl, tid, wave, lane); } else drain_queue<1>(lds, MISC, ctl, tid, wave, lane); \
    xcd_barrier(bar); \
    if (LAST) {   \
        pg8::Gemm g{ACT, WDN, DFF, DFF, DFF, 0}; pg8::StaticOrder S; S.init(SEQ / 256, DM / 256, G, bx); \
        unsigned* fc_ = (unsigned*)(ctl + CW_FCNT); unsigned* tm_ = (unsigned*)(ctl + CW_TMO); \
        EpiResFinal E{HB, HL, out + O_YP, ln_final, SSQ_OUT, fc_, tm_}; pg8::gemm_phase<EpiResFinal, pg8::StaticOrder, false>(lds, g, S, E); \
        small_gemm_t<1, 4>(lds, DM / 8, DFF, DFF, DFF, MapW{ACT + (size_t)SEQ * DFF, WDN, DFF}, EpiResSFinal{HB + (size_t)SEQ * DM, HL + (size_t)SEQ * DM, out + O_YS, ln_final, SSQ_OUT + SEQ, fc_ + 64 * 32, tm_, (unsigned)(DM / 8)}, G, bx); \
    } else {   pg8::Gemm g{ACT, WDN, DFF, DFF, DFF, 0}; pg8::StaticOrder S; S.init(SEQ / 256, DM / 256, G, bx); \
        EpiRes<false> E{nullptr, HB, HL, SSQ_OUT}; pg8::gemm_phase<EpiRes<false>, pg8::StaticOrder, true>(lds, g, S, E); \
        small_gemm_t<1, 4>(lds, DM / 8, DFF, DFF, DFF, MapW{ACT + (size_t)SEQ * DFF, WDN, DFF}, EpiResS<false>{nullptr, HB + (size_t)SEQ * DM, HL + (size_t)SEQ * DM, SSQ_OUT + SEQ}, G, bx); } \
    if (!(LAST)) xcd_barrier(bar);

    MLP_BLOCK(WOUT0, WGU0, WDN0, false, nullptr, nullptr, ssq + MPAD, ssq + 2 * MPAD, false)

    REP(11) {
        pg8::Gemm g{HB, WQKV, DM, DM, DM, 0}; EpiQkv E{ssq + 2 * MPAD, QB, KB, VB, out + O_SKP, out + O_SVP};
        pg8::BalancedOrder S{3, bx, G}; pg8::gemm_phase<EpiQkv, pg8::BalancedOrder, true>(lds, g, S, E);

        small_gemm<2>(lds, 3 * DM / 32, DM, DM, DM, MapW2{HB + (size_t)SEQ * DM, WQKV, DM}, Epi2<EpiQS>{EpiQS{ssq + 2 * MPAD, QB, KB, VB, out + O_SKS, out + O_SVS}}, G, bx);
    }
    xcd_barrier(bar);

    REP(12) {
        for (int uix = bx; uix < 512 + DECB * SH; uix += G) {
            att::UnitDesc D;
            if (uix < 512) { const int h = uix & 15, q5 = (uix >> 4) & 15, qb = uix < 256 ? 31 - q5 : q5;
                D.Q = QB + (size_t)qb * 256 * DM + h * HD; D.Kn = KB + h * HD; D.Vn = VB + h * HD; D.Kc = nullptr; D.Vc = nullptr; D.cpitch = 0; D.npast = 0;
                D.cum = nullptr; D.cstride = 0; D.O = CAT + (size_t)qb * 256 * DM + h * HD; D.P0 = qb * 256; D.nq = 256; D.nk = qb * 256 + 256; D.kmax = 0.f;
                att::unit<1, false>((LAS char*)lds, D);
            } else { const int s = uix - 512, b = s / SH, h = s % SH;
                D.Q = QB + (size_t)(SEQ + b * DECS) * DM + h * HD; D.Kn = KB + (size_t)(SEQ + b * DECS) * DM + h * HD; D.Vn = VB + (size_t)(SEQ + b * DECS) * DM + h * HD;
                D.Kc = c_sk + (size_t)b * PAST * DM + h * HD; D.Vc = c_sv + (size_t)b * PAST * DM + h * HD; D.cpitch = DM; D.npast = PAST;
                D.cum = nullptr; D.cstride = 0; D.O = CAT + (size_t)(SEQ + b * DECS) * DM + h * HD; D.P0 = PAST; D.nq = DECS; D.nk = NKS; D.kmax = 0.f;
                att::unit<1, true>((LAS char*)lds, D);
            }
        }
    }
    drain_queue<3>(lds, MISC, ctl, tid, wave, lane);
    xcd_barrier(bar);

    MLP_BLOCK(WOUT1, WGU1, WDN1, false, nullptr, nullptr, ssq + 3 * MPAD, ssq + 4 * MPAD, true)

}

#undef x_p
#undef x_s
#undef cache_pool
#undef c_fk
#undef c_fv
#undef c_flf
#undef c_sk
#undef c_sv
#undef ln_mix
#undef w_in
#undef b_f
#undef w_pool
#undef pscale
#undef w_out0
#undef w_qkv
#undef w_out1
#undef ln_ffn
#undef w_gate
#undef w_up
#undef w_down
#undef ln_final
#undef out
#undef WIN
#undef WF
#undef WPOOL
#undef WOUT0
#undef WGU0
#undef WDN0
#undef WQKV
#undef WOUT1
#undef WGU1
#undef WDN1
#undef XB
#undef U
#undef UBF
#undef QB
#undef KB
#undef VB
#undef DBF
#undef CAT
#undef HL
#undef HB
#undef ACT
#undef LF
#undef CUMP
#undef CUMS
#undef ssq
#undef SCRH
#undef SCRHB
extern "C" void kernel_launch(void* const* d_in, const int* in_sizes, int n_in, void* d_out, int out_size, void* d_ws, size_t ws_size, hipStream_t stream) {
    static int grid = 0;
    if (grid == 0) {
        if (n_in != 21 || out_size != (int)O_END || ws_size < WS_END) { fprintf(stderr, "kernel_launch: unexpected shapes (n_in %d out %d ws %zu need %zu)\n", n_in, out_size, ws_size, (size_t)WS_END); grid = -1; return; }
        int dev = 0, cus = 0, per_cu = 0;
        if (hipGetDevice(&dev) != hipSuccess || hipDeviceGetAttribute(&cus, hipDeviceAttributeMultiprocessorCount, dev) != hipSuccess) { grid = -1; return; }
        if (hipFuncSetAttribute((const void*)fwd, hipFuncAttributeMaxDynamicSharedMemorySize, LDS_BYTES) != hipSuccess) { fprintf(stderr, "kernel_launch: hipFuncSetAttribute failed\n"); grid = -1; return; }
        if (hipOccupancyMaxActiveBlocksPerMultiprocessor(&per_cu, (const void*)fwd, NT, LDS_BYTES) != hipSuccess || per_cu < 1) { fprintf(stderr, "kernel_launch: occupancy query says %d\n", per_cu); }
        (void)hipGetLastError();
        grid = cus;
    }
    if (grid < 0) return;
    if (hipMemsetAsync((char*)d_ws + WS_CTL, 0, CTL_ZERO_BYTES, stream) != hipSuccess) return;
    Args a{};
    for (int i = 0; i < 21; ++i) a.in[i] = (const float*)d_in[i];
    a.out = (float*)d_out; a.ws = (unsigned char*)d_ws;
    hipLaunchKernelGGL(fwd, dim3(grid), dim3(NT), LDS_BYTES, stream, a);
}
```
